# Optimizing an MI355X kernel written in HIP

```python
import jax, jax.numpy as jnp
from jax import lax
import numpy as np


D_MODEL = 2048
BATCH = 1
SEQ = 8192
DEPTH = 1

CHUNK = 64
N_META = 16
PAD_FRONT = (-N_META) % CHUNK
MIX_WIDTH = D_MODEL
HG_WIDTH = MIX_WIDTH // 2
RET_WIDTH = MIX_WIDTH - HG_WIDTH
HG_HEAD_DIM = 128
HG_HEADS = HG_WIDTH // HG_HEAD_DIM
RET_HEADS = 4
RET_HEAD_DIM = RET_WIDTH // RET_HEADS
D_FF = ((8 * D_MODEL + 3 * 256 - 1) // (3 * 256)) * 256
ROPE_BASE = 10000.0
LN_EPS = 1e-5
HEAD_NORM_EPS = 1e-6
DEEPNORM_ALPHA = (2.0 * DEPTH) ** 0.25
DEEPNORM_BETA = (8.0 * DEPTH) ** -0.25
PROJ_WIDTHS = (HG_WIDTH,) * 4 + (RET_WIDTH,) * 4
PROJ_SPLITS = tuple(int(s) for s in np.cumsum(PROJ_WIDTHS)[:-1])
N_PROJ = sum(PROJ_WIDTHS)

kernel_name = 'hybrid_hgrn2_retention_deepnorm_encoder'


def layer_norm(x, g, b):
    xf = x.astype(jnp.float32)
    mu = jnp.mean(xf, axis=-1, keepdims=True)
    var = jnp.mean(jnp.square(xf - mu), axis=-1, keepdims=True)
    y = (xf - mu) * lax.rsqrt(var + LN_EPS)
    return (y * g.astype(jnp.float32) + b.astype(jnp.float32)).astype(x.dtype)


def rotary(x, pos):
    half = x.shape[-1] // 2
    inv_freq = ROPE_BASE ** (-jnp.arange(half, dtype=jnp.float32) / half)
    ang = pos.astype(jnp.float32)[:, None] * inv_freq[None, :]
    cos = jnp.cos(ang)[None, :, None, :]
    sin = jnp.sin(ang)[None, :, None, :]
    x1, x2 = x[..., :half], x[..., half:]
    return jnp.concatenate([x1 * cos - x2 * sin, x1 * sin + x2 * cos], axis=-1)


def hgrn2_group(q, f_pre, i, g, lb, valid, norm_g):
    b_sz, length, _ = q.shape
    n_chunks = length // CHUNK
    f32 = jnp.float32
    m = valid[None, :, None]
    q = jax.nn.silu(q.astype(f32)) * (HG_HEAD_DIM ** -0.5)
    forget = lb + (1.0 - lb) * jax.nn.sigmoid(f_pre.astype(f32))
    log_f = jnp.where(m, jnp.log(forget), 0.0)
    k = jnp.where(m, 1.0 - forget, 0.0)
    v = i.astype(f32)

    def to_chunks(t):
        return t.reshape(b_sz, n_chunks, CHUNK, HG_HEADS, HG_HEAD_DIM).transpose(1, 0, 3, 2, 4)

    causal = jnp.tril(jnp.ones((CHUNK, CHUNK), dtype=bool))[:, :, None]

    def step(state, inp):
        qc, kc, vc, gc = inp
        cum = jnp.cumsum(gc, axis=2)
        diff = cum[:, :, :, None, :] - cum[:, :, None, :, :]
        decay = jnp.exp(jnp.where(causal, diff, -jnp.inf))
        scores = jnp.einsum('bhtk,bhsk,bhtsk->bhts', qc, kc, decay)
        out = (jnp.einsum('bhts,bhsv->bhtv', scores, vc)
               + jnp.einsum('bhtk,bhkv->bhtv', qc * jnp.exp(cum), state))
        last = cum[:, :, -1:, :]
        state = (jnp.exp(last[:, :, 0, :])[..., None] * state
                 + jnp.einsum('bhsk,bhsv->bhkv', kc * jnp.exp(last - cum), vc))
        return state, out

    s0 = jnp.zeros((b_sz, HG_HEADS, HG_HEAD_DIM, HG_HEAD_DIM), f32)
    _, o = lax.scan(step, s0, (to_chunks(q), to_chunks(k), to_chunks(v), to_chunks(log_f)))
    o = o.transpose(1, 0, 3, 2, 4).reshape(b_sz, length, HG_HEADS, HG_HEAD_DIM)
    o = o * lax.rsqrt(jnp.mean(jnp.square(o), axis=-1, keepdims=True) + HEAD_NORM_EPS)
    o = o.reshape(b_sz, length, HG_WIDTH) * norm_g.astype(f32)
    return o * jax.nn.silu(g.astype(f32))


def retention_group(q, k, v, g, pos, valid, norm_g, norm_b):
    b_sz, length, _ = q.shape
    n_chunks = length // CHUNK
    f32 = jnp.float32
    qh = rotary(q.astype(f32).reshape(b_sz, length, RET_HEADS, RET_HEAD_DIM), pos)
    kh = rotary(k.astype(f32).reshape(b_sz, length, RET_HEADS, RET_HEAD_DIM), pos) * (RET_HEAD_DIM ** -0.5)
    kh = jnp.where(valid[None, :, None, None], kh, 0.0)
    vh = v.astype(f32).reshape(b_sz, length, RET_HEADS, RET_HEAD_DIM)
    log_gamma = jnp.log(1.0 - 2.0 ** (-5.0 - jnp.arange(RET_HEADS, dtype=f32)))

    def to_chunks(t):
        return t.reshape(b_sz, n_chunks, CHUNK, RET_HEADS, RET_HEAD_DIM).transpose(0, 3, 1, 2, 4)

    qc, kc, vc = to_chunks(qh), to_chunks(kh), to_chunks(vh)
    j = jnp.arange(CHUNK, dtype=f32)
    rel = j[:, None] - j[None, :]
    intra_decay = jnp.where(rel[None] >= 0,
                            jnp.exp(jnp.maximum(rel, 0.0)[None] * log_gamma[:, None, None]), 0.0)
    scores = jnp.einsum('bhntd,bhnsd->bhnts', qc, kc) * intra_decay[None, :, None]
    o = jnp.einsum('bhnts,bhnsv->bhntv', scores, vc)
    k_dec = kc * jnp.exp((CHUNK - 1.0 - j)[None, :] * log_gamma[:, None])[None, :, None, :, None]
    kv = jnp.einsum('bhnsd,bhnsv->nbhdv', k_dec, vc)
    chunk_decay = jnp.exp(CHUNK * log_gamma)[None, :, None, None]

    def step(state, kv_n):
        return chunk_decay * state + kv_n, state

    r0 = jnp.zeros((b_sz, RET_HEADS, RET_HEAD_DIM, RET_HEAD_DIM), f32)
    _, r_prev = lax.scan(step, r0, kv)
    q_dec = qc * jnp.exp((j + 1.0)[None, :] * log_gamma[:, None])[None, :, None, :, None]
    o = o + jnp.einsum('bhntd,nbhdv->bhntv', q_dec, r_prev)
    o = o.transpose(0, 2, 3, 1, 4).reshape(b_sz, length, RET_HEADS, RET_HEAD_DIM)
    mu = jnp.mean(o, axis=-1, keepdims=True)
    var = jnp.mean(jnp.square(o - mu), axis=-1, keepdims=True)
    o = ((o - mu) * lax.rsqrt(var + HEAD_NORM_EPS)).reshape(b_sz, length, RET_WIDTH)
    o = o * norm_g.astype(f32) + norm_b.astype(f32)
    return o * jax.nn.silu(g.astype(f32))


def setup_inputs(seed: int = 0) -> dict:
    key = jax.random.key(seed)
    ks = jax.random.split(key, 20)
    f32 = jnp.float32
    nrm = lambda k, shape: jax.random.normal(k, shape, f32)
    beta = DEEPNORM_BETA
    col_scale = np.concatenate([np.full((w,), s, np.float32) for w, s in zip(
        PROJ_WIDTHS, (1.0, 1.0, beta, 1.0, 1.0, 1.0, beta, 1.0))])
    x = nrm(ks[0], (BATCH, SEQ, D_MODEL))
    meta_tokens = nrm(ks[1], (N_META, D_MODEL))
    ln_in_g = 1.0 + 0.02 * nrm(ks[2], (D_MODEL,))
    ln_in_b = 0.02 * nrm(ks[3], (D_MODEL,))
    hg_lower_bounds = 0.1 * nrm(ks[4], (DEPTH + 1, HG_WIDTH))
    w_in = nrm(ks[5], (DEPTH, D_MODEL, N_PROJ)) * (D_MODEL ** -0.5) * jnp.asarray(col_scale)
    hg_norm_g = 1.0 + 0.02 * nrm(ks[6], (DEPTH, HG_WIDTH))
    ret_norm_g = 1.0 + 0.02 * nrm(ks[7], (DEPTH, RET_WIDTH))
    ret_norm_b = 0.02 * nrm(ks[8], (DEPTH, RET_WIDTH))
    w_out = nrm(ks[9], (DEPTH, MIX_WIDTH, D_MODEL)) * (MIX_WIDTH ** -0.5) * beta
    ln1_g = 1.0 + 0.02 * nrm(ks[10], (DEPTH, D_MODEL))
    ln1_b = 0.02 * nrm(ks[11], (DEPTH, D_MODEL))
    w_gate = nrm(ks[12], (DEPTH, D_MODEL, D_FF)) * (D_MODEL ** -0.5) * beta
    w_up = nrm(ks[13], (DEPTH, D_MODEL, D_FF)) * (D_MODEL ** -0.5) * beta
    w_down = nrm(ks[14], (DEPTH, D_FF, D_MODEL)) * (D_FF ** -0.5) * beta
    ln2_g = 1.0 + 0.02 * nrm(ks[15], (DEPTH, D_MODEL))
    ln2_b = 0.02 * nrm(ks[16], (DEPTH, D_MODEL))
    return {'x': x, 'meta_tokens': meta_tokens, 'ln_in_g': ln_in_g, 'ln_in_b': ln_in_b,
            'hg_lower_bounds': hg_lower_bounds, 'w_in': w_in, 'hg_norm_g': hg_norm_g,
            'ret_norm_g': ret_norm_g, 'ret_norm_b': ret_norm_b, 'w_out': w_out,
            'ln1_g': ln1_g, 'ln1_b': ln1_b, 'w_gate': w_gate, 'w_up': w_up, 'w_down': w_down,
            'ln2_g': ln2_g, 'ln2_b': ln2_b}


def reference(x, meta_tokens, ln_in_g, ln_in_b, hg_lower_bounds, w_in, hg_norm_g, ret_norm_g,
              ret_norm_b, w_out, ln1_g, ln1_b, w_gate, w_up, w_down, ln2_g, ln2_b):
    b_sz, seq, _ = x.shape
    length = PAD_FRONT + N_META + seq
    pad = jnp.zeros((b_sz, PAD_FRONT, D_MODEL), x.dtype)
    meta = jnp.broadcast_to(meta_tokens.astype(x.dtype)[None], (b_sz, N_META, D_MODEL))
    h = layer_norm(jnp.concatenate([pad, meta, x], axis=1), ln_in_g, ln_in_b)
    pos = jnp.arange(length, dtype=jnp.int32) - PAD_FRONT
    valid = pos >= 0
    lb_all = jnp.cumsum(jax.nn.softmax(hg_lower_bounds.astype(jnp.float32), axis=0), axis=0)
    for layer in range(DEPTH):
        proj = h @ w_in[layer]
        hg_q, hg_f, hg_i, hg_g, r_q, r_k, r_v, r_g = jnp.split(proj, PROJ_SPLITS, axis=-1)
        o_hg = hgrn2_group(hg_q, hg_f, hg_i, hg_g, lb_all[layer], valid, hg_norm_g[layer])
        o_ret = retention_group(r_q, r_k, r_v, r_g, pos, valid, ret_norm_g[layer], ret_norm_b[layer])
        mix = jnp.concatenate([o_hg, o_ret], axis=-1).astype(h.dtype) @ w_out[layer]
        h = layer_norm(DEEPNORM_ALPHA * h + mix, ln1_g[layer], ln1_b[layer])
        ff = (jax.nn.silu(h @ w_gate[layer]) * (h @ w_up[layer])) @ w_down[layer]
        h = layer_norm(DEEPNORM_ALPHA * h + ff, ln2_g[layer], ln2_b[layer])
    return h[:, PAD_FRONT + N_META:, :]
```

```cpp
#include <hip/hip_runtime.h>
#include <stdint.h>
#include <math.h>

typedef unsigned short bf16_t;
__device__ __forceinline__ float bf2f(bf16_t v) { return __uint_as_float((unsigned)v << 16); }
__device__ __forceinline__ bf16_t f2bf(float f) { unsigned u = __float_as_uint(f); return (bf16_t)((u + 0x7fffu + ((u >> 16) & 1u)) >> 16); }

constexpr int DM = 2048, SEQ = 8192, LT = 8256, NPROJ = 8192, DFF = 5632, PADM = 64  , PADF = 48;
constexpr float ALPHA = 1.18920711500272f;
constexpr size_t MiB = 1u << 20;
constexpr size_t WS_LB = 0;
constexpr size_t WS_INVF = 64 * 1024;
constexpr size_t WS_ST0 = 128 * 1024;
constexpr size_t WS_ST1 = 256 * 1024;
constexpr size_t WS_H0B = 1 * MiB;
constexpr size_t WS_PROJ = 34 * MiB;
constexpr size_t WS_LOGF = 163 * MiB;
constexpr size_t WS_MIX = 196 * MiB;
constexpr size_t WS_Z = 34 * MiB;
constexpr size_t WS_H1B = 98 * MiB;
constexpr size_t WS_ACT = 130 * MiB;

__device__ __forceinline__ float wave_sum(float v) {
#pragma unroll
    for (int o = 1; o < 64; o <<= 1) v += __shfl_xor(v, o);
    return v;
}
__device__ __forceinline__ float block_sum256(float v, float* sm) {
    v = wave_sum(v);
    __syncthreads();
    if ((threadIdx.x & 63) == 0) sm[threadIdx.x >> 6] = v;
    __syncthreads();
    return (sm[0] + sm[1]) + (sm[2] + sm[3]);
}

__global__ void k_invf(float* invf) {
    int d = threadIdx.x;
    if (d < 128) invf[d] = (float)pow(10000.0, -(double)d / 128.0);
}

__global__ __launch_bounds__(256) void k_ln_in(const float* __restrict__ x, const float* __restrict__ meta, const float* __restrict__ g, const float* __restrict__ b,
                                               bf16_t* __restrict__ H0B, float* __restrict__ ST0) {
    __shared__ float sm[4];
    const int t = blockIdx.x, tid = threadIdx.x;
    const float* src = nullptr;
    if (t >= PADM) src = x + (size_t)(t - PADM) * DM; else if (t >= PADF) src = meta + (size_t)(t - PADF) * DM;
    float v[8]; float s = 0.f;
#pragma unroll
    for (int i = 0; i < 8; ++i) { v[i] = src ? src[tid + 256 * i] : 0.f; s += v[i]; }
    const float mu = block_sum256(s, sm) * (1.f / DM);
    float q = 0.f;
#pragma unroll
    for (int i = 0; i < 8; ++i) { const float d = v[i] - mu; q += d * d; }
    const float var = block_sum256(q, sm) * (1.f / DM);
    const float rstd = 1.0f / sqrtf(var + 1e-5f);
#pragma unroll
    for (int i = 0; i < 8; ++i) { const int c = tid + 256 * i; H0B[(size_t)t * DM + c] = f2bf((v[i] - mu) * rstd * g[c] + b[c]); }
    if (tid == 0) { ST0[2 * t] = mu; ST0[2 * t + 1] = rstd; }
}

__global__ __launch_bounds__(256) void k_ln_rows(const float* in, const float* __restrict__ g, const float* __restrict__ b, bf16_t* outb, float* outf, float* st) {
    __shared__ float sm[4];
    const int t = blockIdx.x, tid = threadIdx.x;
    const float* src = in + (size_t)t * DM;
    float v[8]; float s = 0.f;
#pragma unroll
    for (int i = 0; i < 8; ++i) { v[i] = src[tid + 256 * i]; s += v[i]; }
    const float mu = block_sum256(s, sm) * (1.f / DM);
    float q = 0.f;
#pragma unroll
    for (int i = 0; i < 8; ++i) { const float d = v[i] - mu; q += d * d; }
    const float var = block_sum256(q, sm) * (1.f / DM);
    const float rstd = 1.0f / sqrtf(var + 1e-5f);
#pragma unroll
    for (int i = 0; i < 8; ++i) { const int c = tid + 256 * i; const float y = (v[i] - mu) * rstd * g[c] + b[c];
        if (outb) outb[(size_t)t * DM + c] = f2bf(y);
        if (outf) outf[(size_t)t * DM + c] = y; }
    if (st && tid == 0) { st[2 * t] = mu; st[2 * t + 1] = rstd; }
}

__device__ __forceinline__ float silu_f(float x) { return x / (1.0f + expf(-x)); }
__device__ __forceinline__ float sigmoid_f(float x) { return 1.0f / (1.0f + expf(-x)); }

struct GemmP {
    const bf16_t* A; int lda; const float* B1; const float* B2; int ldb; int K;
    bf16_t* outb; float* outf; float* outf2;
    const float* aux0; const float* aux1; const float* aux2; const float* aux3; const float* aux4;
};
enum { MODE_HG = 0, MODE_RQ = 1, MODE_RK = 2, MODE_RVG = 3, MODE_OUT = 4, MODE_GU = 5, MODE_DOWN = 6 };

template <int MODE> __global__ __launch_bounds__(256) void k_gemm(GemmP p) {
    constexpr bool DUAL = (MODE == MODE_RQ || MODE == MODE_RK || MODE == MODE_GU);
    __shared__ float As[16][68];
    __shared__ float Bs1[16][64];
    __shared__ float Bs2[DUAL ? 16 : 1][64];
    const int tid = threadIdx.x, ty = tid >> 4, tx = tid & 15;
    const int bm = blockIdx.y * 64, bn = blockIdx.x * 64;
    int bcol1 = bn, bcol2 = bn;
    if (MODE == MODE_RQ || MODE == MODE_RK) { const int head = bn >> 7, d0 = bn & 127; bcol1 = head * 256 + d0; bcol2 = bcol1 + 128; }
    float acc1[4][4], acc2[4][4];
#pragma unroll
    for (int i = 0; i < 4; ++i)
#pragma unroll
        for (int j = 0; j < 4; ++j) { acc1[i][j] = 0.f; acc2[i][j] = 0.f; }
    const int ar = tid >> 2, ak = (tid & 3) * 4;
    const int bk = tid >> 4, bc = (tid & 15) * 4;
    for (int k0 = 0; k0 < p.K; k0 += 16) {
        {
            const bf16_t* ap = p.A + (size_t)(bm + ar) * p.lda + k0 + ak;
            const uint2 raw = *(const uint2*)ap;
            As[ak + 0][ar] = __uint_as_float(raw.x << 16); As[ak + 1][ar] = __uint_as_float(raw.x & 0xffff0000u);
            As[ak + 2][ar] = __uint_as_float(raw.y << 16); As[ak + 3][ar] = __uint_as_float(raw.y & 0xffff0000u);
            const float4 b1 = *(const float4*)(p.B1 + (size_t)(k0 + bk) * p.ldb + bcol1 + bc);
            *(float4*)&Bs1[bk][bc] = b1;
            if (DUAL) { const float4 b2 = *(const float4*)(p.B2 + (size_t)(k0 + bk) * p.ldb + bcol2 + bc); *(float4*)&Bs2[bk][bc] = b2; }
        }
        __syncthreads();
#pragma unroll
        for (int kk = 0; kk < 16; ++kk) {
            const float4 a = *(const float4*)&As[kk][ty * 4];
            const float4 b = *(const float4*)&Bs1[kk][tx * 4];
            const float av[4] = {a.x, a.y, a.z, a.w}; const float bv[4] = {b.x, b.y, b.z, b.w};
#pragma unroll
            for (int i = 0; i < 4; ++i)
#pragma unroll
                for (int j = 0; j < 4; ++j) acc1[i][j] = fmaf(av[i], bv[j], acc1[i][j]);
            if (DUAL) {
                const float4 b2 = *(const float4*)&Bs2[kk][tx * 4];
                const float bw[4] = {b2.x, b2.y, b2.z, b2.w};
#pragma unroll
                for (int i = 0; i < 4; ++i)
#pragma unroll
                    for (int j = 0; j < 4; ++j) acc2[i][j] = fmaf(av[i], bw[j], acc2[i][j]);
            }
        }
        __syncthreads();
    }
#pragma unroll
    for (int i = 0; i < 4; ++i) {
        const int r = bm + ty * 4 + i;
#pragma unroll
        for (int j = 0; j < 4; ++j) {
            const int c = bn + tx * 4 + j;
            const float v1 = acc1[i][j], v2 = acc2[i][j];
            if (MODE == MODE_HG) {
                const int grp = c >> 10, cg = c & 1023; const bool valid = r >= PADF;
                if (grp == 0) p.outb[(size_t)r * NPROJ + c] = f2bf(silu_f(v1) * 0.08838834764831845f);
                else if (grp == 1) {
                    const float a0 = p.aux0[cg], a1 = p.aux0[1024 + cg];
                    const float lb = 1.0f / (1.0f + expf(a1 - a0));
                    const float forget = lb + (1.0f - lb) * sigmoid_f(v1);
                    p.outf[(size_t)r * 1024 + cg] = valid ? logf(forget) : 0.f;
                    p.outb[(size_t)r * NPROJ + c] = f2bf(valid ? 1.0f - forget : 0.f);
                } else if (grp == 2) p.outb[(size_t)r * NPROJ + c] = f2bf(v1);
                else p.outb[(size_t)r * NPROJ + c] = f2bf(silu_f(v1));
            } else if (MODE == MODE_RQ || MODE == MODE_RK) {
                const int head = c >> 7, d = c & 127; const int pos = r - PADF;
                const float ang = (float)pos * p.aux0[d];
                const float cs = (float)cos((double)ang), sn = (float)sin((double)ang);
                float o1 = v1 * cs - v2 * sn, o2 = v1 * sn + v2 * cs;
                if (MODE == MODE_RK) { const bool valid = r >= PADF; o1 = valid ? o1 * 0.0625f : 0.f; o2 = valid ? o2 * 0.0625f : 0.f; }
                const size_t base = (size_t)r * NPROJ + (MODE == MODE_RQ ? 4096 : 5120) + head * 256 + d;
                p.outb[base] = f2bf(o1); p.outb[base + 128] = f2bf(o2);
            } else if (MODE == MODE_RVG) {
                p.outb[(size_t)r * NPROJ + 6144 + c] = f2bf(c < 1024 ? v1 : silu_f(v1));
            } else if (MODE == MODE_OUT) {
                const float xv = p.aux0[(size_t)r * DM + c]; const float mu = p.aux1[2 * (r + PADM)], rstd = p.aux1[2 * (r + PADM) + 1];
                const float h0 = (xv - mu) * rstd * p.aux2[c] + p.aux3[c];
                p.outf[(size_t)r * DM + c] = ALPHA * h0 + v1;
            } else if (MODE == MODE_GU) {
                p.outb[(size_t)r * DFF + c] = f2bf(silu_f(v1) * v2);
            } else if (MODE == MODE_DOWN) {
                const float zv = p.aux0[(size_t)r * DM + c]; const float mu = p.aux1[2 * r], rstd = p.aux1[2 * r + 1];
                const float h1 = (zv - mu) * rstd * p.aux2[c] + p.aux3[c];
                p.outf[(size_t)r * DM + c] = ALPHA * h1 + v1;
            }
        }
    }
}

__global__ __launch_bounds__(64) void k_hgrn_rec(const bf16_t* __restrict__ PROJ, const float* __restrict__ LOGF, float* __restrict__ HGO) {
    const int h = blockIdx.x >> 1, v = (blockIdx.x & 1) * 64 + threadIdx.x;
    float S[128];
#pragma unroll
    for (int k = 0; k < 128; ++k) S[k] = 0.f;
    for (int t = 0; t < LT; ++t) {
        const float* lf = LOGF + (size_t)t * 1024 + h * 128;
        const bf16_t* q = PROJ + (size_t)t * NPROJ + h * 128;
        const bf16_t* kk = q + 1024;
        const float vv = bf2f(PROJ[(size_t)t * NPROJ + 2048 + h * 128 + v]);
        float o = 0.f;
#pragma unroll
        for (int k = 0; k < 128; ++k) {
            const float f = expf(lf[k]);
            S[k] = f * S[k] + bf2f(kk[k]) * vv;
            o = fmaf(bf2f(q[k]), S[k], o);
        }
        if (t >= PADM) HGO[(size_t)(t - PADM) * 1024 + h * 128 + v] = o;
    }
}

__global__ __launch_bounds__(64) void k_ret_rec(const bf16_t* __restrict__ PROJ, float* __restrict__ RETO) {
    const int h = blockIdx.x >> 3, v = (blockIdx.x & 7) * 32 + (threadIdx.x & 31), kh = threadIdx.x >> 5;
    const float gamma = 1.0f - exp2f(-5.0f - (float)h);
    float S[128];
#pragma unroll
    for (int k = 0; k < 128; ++k) S[k] = 0.f;
    for (int t = 0; t < LT; ++t) {
        const uint4* q4 = (const uint4*)(PROJ + (size_t)t * NPROJ + 4096 + h * 256 + kh * 128);
        const uint4* k4 = (const uint4*)(PROJ + (size_t)t * NPROJ + 5120 + h * 256 + kh * 128);
        const float vv = bf2f(PROJ[(size_t)t * NPROJ + 6144 + h * 256 + v]);
        float o = 0.f;
#pragma unroll
        for (int c = 0; c < 16; ++c) {
            const uint4 qa = q4[c], ka = k4[c];
            const unsigned qw[4] = {qa.x, qa.y, qa.z, qa.w}, kw[4] = {ka.x, ka.y, ka.z, ka.w};
#pragma unroll
            for (int e = 0; e < 4; ++e) {
                const float q0 = __uint_as_float(qw[e] << 16), q1 = __uint_as_float(qw[e] & 0xffff0000u);
                const float k0 = __uint_as_float(kw[e] << 16), k1 = __uint_as_float(kw[e] & 0xffff0000u);
                const int i0 = c * 8 + e * 2;
                S[i0] = gamma * S[i0] + k0 * vv; o = fmaf(q0, S[i0], o);
                S[i0 + 1] = gamma * S[i0 + 1] + k1 * vv; o = fmaf(q1, S[i0 + 1], o);
            }
        }
        o += __shfl_xor(o, 32);
        if (t >= PADM && kh == 0) RETO[(size_t)(t - PADM) * 1024 + h * 256 + v] = o;
    }
}

__global__ __launch_bounds__(256) void k_mixnorm(const float* __restrict__ HGO, const float* __restrict__ RETO, const bf16_t* __restrict__ PROJ,
                                                 const float* __restrict__ hg_ng, const float* __restrict__ ret_ng, const float* __restrict__ ret_nb, bf16_t* __restrict__ MIX) {
    const int r = blockIdx.x, tid = threadIdx.x; const int t = r + PADM;
    {
        const int c0 = tid * 4; float o[4]; float s = 0.f;
#pragma unroll
        for (int i = 0; i < 4; ++i) { o[i] = HGO[(size_t)r * 1024 + c0 + i]; s += o[i] * o[i]; }
#pragma unroll
        for (int m = 1; m < 32; m <<= 1) s += __shfl_xor(s, m);
        const float rs = 1.0f / sqrtf(s * (1.f / 128.f) + 1e-6f);
#pragma unroll
        for (int i = 0; i < 4; ++i) { const float sg = bf2f(PROJ[(size_t)t * NPROJ + 3072 + c0 + i]); MIX[(size_t)r * DM + c0 + i] = f2bf(o[i] * rs * hg_ng[c0 + i] * sg); }
    }
    {
        const int c0 = tid * 4; float o[4]; float s = 0.f;
#pragma unroll
        for (int i = 0; i < 4; ++i) { o[i] = RETO[(size_t)r * 1024 + c0 + i]; s += o[i]; }
        const float mu = wave_sum(s) * (1.f / 256.f); float q = 0.f;
#pragma unroll
        for (int i = 0; i < 4; ++i) { const float d = o[i] - mu; q += d * d; }
        const float rs = 1.0f / sqrtf(wave_sum(q) * (1.f / 256.f) + 1e-6f);
#pragma unroll
        for (int i = 0; i < 4; ++i) { const float sg = bf2f(PROJ[(size_t)t * NPROJ + 7168 + c0 + i]);
            MIX[(size_t)r * DM + 1024 + c0 + i] = f2bf(((o[i] - mu) * rs * ret_ng[c0 + i] + ret_nb[c0 + i]) * sg); }
    }
}

extern "C" void kernel_launch(void* const* d_in, const int* in_sizes, int n_in, void* d_out, int out_size, void* d_ws, size_t ws_size, hipStream_t stream) {
    const float* x = (const float*)d_in[0]; const float* meta = (const float*)d_in[1]; const float* ln_in_g = (const float*)d_in[2]; const float* ln_in_b = (const float*)d_in[3];
    const float* hlb = (const float*)d_in[4]; const float* w_in = (const float*)d_in[5]; const float* hg_ng = (const float*)d_in[6]; const float* ret_ng = (const float*)d_in[7];
    const float* ret_nb = (const float*)d_in[8]; const float* w_out = (const float*)d_in[9]; const float* ln1_g = (const float*)d_in[10]; const float* ln1_b = (const float*)d_in[11];
    const float* w_gate = (const float*)d_in[12]; const float* w_up = (const float*)d_in[13]; const float* w_down = (const float*)d_in[14];
    const float* ln2_g = (const float*)d_in[15]; const float* ln2_b = (const float*)d_in[16];
    unsigned char* ws = (unsigned char*)d_ws; float* out = (float*)d_out;
    float* INVF = (float*)(ws + WS_INVF); float* ST0 = (float*)(ws + WS_ST0); float* ST1 = (float*)(ws + WS_ST1);
    bf16_t* H0B = (bf16_t*)(ws + WS_H0B); bf16_t* PROJ = (bf16_t*)(ws + WS_PROJ); float* LOGF = (float*)(ws + WS_LOGF); bf16_t* MIX = (bf16_t*)(ws + WS_MIX);
    float* Z = (float*)(ws + WS_Z); bf16_t* H1B = (bf16_t*)(ws + WS_H1B); bf16_t* ACT = (bf16_t*)(ws + WS_ACT);
    float* HGO = out; float* RETO = out + (size_t)SEQ * 1024;

    k_invf<<<1, 128, 0, stream>>>(INVF);
    k_ln_in<<<LT, 256, 0, stream>>>(x, meta, ln_in_g, ln_in_b, H0B, ST0);
    {   GemmP p{}; p.A = H0B; p.lda = DM; p.ldb = NPROJ; p.K = DM; p.outb = PROJ; p.outf = LOGF;
        p.B1 = w_in; p.B2 = w_in; p.aux0 = hlb;
        k_gemm<MODE_HG><<<dim3(4096 / 64, LT / 64), 256, 0, stream>>>(p);
        p.B1 = w_in + 4096; p.B2 = w_in + 4096; p.aux0 = INVF;
        k_gemm<MODE_RQ><<<dim3(512 / 64, LT / 64), 256, 0, stream>>>(p);
        p.B1 = w_in + 5120; p.B2 = w_in + 5120;
        k_gemm<MODE_RK><<<dim3(512 / 64, LT / 64), 256, 0, stream>>>(p);
        p.B1 = w_in + 6144; p.B2 = p.B1;
        k_gemm<MODE_RVG><<<dim3(2048 / 64, LT / 64), 256, 0, stream>>>(p);
    }
    k_hgrn_rec<<<16, 64, 0, stream>>>(PROJ, LOGF, HGO);
    k_ret_rec<<<32, 64, 0, stream>>>(PROJ, RETO);
    k_mixnorm<<<SEQ, 256, 0, stream>>>(HGO, RETO, PROJ, hg_ng, ret_ng, ret_nb, MIX);
    {   GemmP p{}; p.A = MIX; p.lda = DM; p.B1 = w_out; p.B2 = w_out; p.ldb = DM; p.K = DM; p.outf = Z;
        p.aux0 = x; p.aux1 = ST0; p.aux2 = ln_in_g; p.aux3 = ln_in_b;
        k_gemm<MODE_OUT><<<dim3(DM / 64, SEQ / 64), 256, 0, stream>>>(p);
    }
    k_ln_rows<<<SEQ, 256, 0, stream>>>(Z, ln1_g, ln1_b, H1B, nullptr, ST1);
    {   GemmP p{}; p.A = H1B; p.lda = DM; p.B1 = w_gate; p.B2 = w_up; p.ldb = DFF; p.K = DM; p.outb = ACT;
        k_gemm<MODE_GU><<<dim3(DFF / 64, SEQ / 64), 256, 0, stream>>>(p);
    }
    {   GemmP p{}; p.A = ACT; p.lda = DFF; p.B1 = w_down; p.B2 = w_down; p.ldb = DM; p.K = DFF; p.outf = out;
        p.aux0 = Z; p.aux1 = ST1; p.aux2 = ln1_g; p.aux3 = ln1_b;
        k_gemm<MODE_DOWN><<<dim3(DM / 64, SEQ / 64), 256, 0, stream>>>(p);
    }
    k_ln_rows<<<SEQ, 256, 0, stream>>>(out, ln2_g, ln2_b, nullptr, out, nullptr);
}
```

```cpp
#include <hip/hip_runtime.h>
#include <cstdio>
#include <cstdint>
#include <math.h>

namespace pg8 {
#define PG8_LAS __attribute__((address_space(3)))
typedef unsigned short bf16_t;
typedef short bf16x8 __attribute__((ext_vector_type(8)));
typedef float f32x4 __attribute__((ext_vector_type(4)));
typedef unsigned u32x4 __attribute__((ext_vector_type(4)));
constexpr int BM = 256, BK = 64, HALF = 128, HTB = HALF * BK * 2  , STAGE_BYTES = 8 * HTB, NXCD = 8, WGM = 8;

__host__ __device__ __forceinline__ int lds_byte(int r, int c) { const int st = (r >> 4) * 2 + (c >> 5), rr = r & 15, cc = c & 31, ob = rr * 64 + cc * 2; return st * 1024 + (ob ^ (((ob >> 9) & 1) << 5)); }
__host__ __device__ __forceinline__ void stage_rc(int b, int& R, int& C) { const int st = b / 1024, sb = b % 1024, swz = sb ^ (((sb >> 9) & 1) << 5); R = (st >> 1) * 16 + swz / 64; C = (st & 1) * 32 + (swz % 64) / 2; }
__host__ __device__ __forceinline__ int perm32(int rho) { const int n = rho >> 4, i = rho & 15; return 8 * (i >> 2) + 4 * n + (i & 3); }

struct Unit { int pm, pn; };
struct Gemm { const bf16_t* A; const bf16_t* Bt; int M, N, K; };

struct StaticOrder {
    int nM, nN, nwg, G, c;
    __host__ __device__ void init(int M, int N, int G_, int c_) { nM = M / BM; nN = N / BM; nwg = nM * nN; G = G_; c = c_; }
    __host__ __device__ bool next(int i, Unit& u) const {
        const long L = (long)i * G + c; if (L >= nwg) return false;
        int wgid = (int)L; { const int q = nwg / NXCD, r = nwg % NXCD, xcd = wgid % NXCD, off = wgid / NXCD; wgid = (xcd < r ? xcd * (q + 1) : r * (q + 1) + (xcd - r) * q) + off; }
        const int nig = WGM * nN, gid = wgid / nig, fm = gid * WGM, gsz = (nM - fm) < WGM ? (nM - fm) : WGM;
        u.pm = fm + ((wgid % nig) % gsz); u.pn = (wgid % nig) / gsz; return true;
    }
    __device__ __forceinline__ void a_ready(const Unit&) const {}
    __device__ __forceinline__ void done(const Unit&) const {}
};

__device__ __forceinline__ unsigned cvt_pk_bf16(float lo, float hi) { unsigned r; asm volatile("v_cvt_pk_bf16_f32 %0, %1, %2" : "=v"(r) : "v"(lo), "v"(hi)); return r; }
__device__ __forceinline__ float fexp(float x) { return __builtin_amdgcn_exp2f(x * 1.4426950408889634f); }
__device__ __forceinline__ float silu_f(float x) { return x * __builtin_amdgcn_rcpf(1.0f + fexp(-x)); }
__device__ __forceinline__ float sigmoid_f(float x) { return __builtin_amdgcn_rcpf(1.0f + fexp(-x)); }

constexpr int NPROJ = 8192, DM = 2048, DFF = 5632, PADM = 64;
constexpr float ALPHA = 1.18920711500272f;


struct EpiProj {
    static constexpr bool PERM = true, AFTER_DRAIN = false;
    bf16_t* PROJ; float* LOGF; const float* LB; const float* RC; const float* RS;
    __device__ __forceinline__ void operator()(const f32x4 (&acc)[2][2][4][2], const Unit& u, int wr, int wc, int fr, int fq) const {
        const int cgp = u.pn >> 2, row0 = u.pm * BM + wr * 64 + fr, cl = wc * 32 + 8 * fq;
        if (cgp == 4 || cgp == 5) {
            const float sc = (cgp == 5) ? 0.0625f : 1.0f;
#pragma unroll
            for (int ai = 0; ai < 2; ++ai)
#pragma unroll
                for (int m = 0; m < 4; ++m) {
                    const int t = row0 + ai * HALF + m * 16 + PADM;
                    u32x4 w1, w2;
#pragma unroll
                    for (int n = 0; n < 2; ++n) {
                        const f32x4 cs = *(const f32x4*)(RC + (size_t)t * 128 + cl + 4 * n), sn = *(const f32x4*)(RS + (size_t)t * 128 + cl + 4 * n);
                        const f32x4 x1 = acc[ai][0][m][n], x2 = acc[ai][1][m][n];
                        const f32x4 o1 = (x1 * cs - x2 * sn) * sc, o2 = (x1 * sn + x2 * cs) * sc;
                        if (n == 0) { w1.x = cvt_pk_bf16(o1[0], o1[1]); w1.y = cvt_pk_bf16(o1[2], o1[3]); w2.x = cvt_pk_bf16(o2[0], o2[1]); w2.y = cvt_pk_bf16(o2[2], o2[3]); }
                        else        { w1.z = cvt_pk_bf16(o1[0], o1[1]); w1.w = cvt_pk_bf16(o1[2], o1[3]); w2.z = cvt_pk_bf16(o2[0], o2[1]); w2.w = cvt_pk_bf16(o2[2], o2[3]); }
                    }
                    bf16_t* rowp = PROJ + (size_t)t * NPROJ + u.pn * BM + cl;
                    *(u32x4*)rowp = w1; *(u32x4*)(rowp + HALF) = w2;
                }
        } else {
#pragma unroll
            for (int bj = 0; bj < 2; ++bj) {
                const int c0 = u.pn * BM + bj * HALF + cl;
                f32x4 lb0 = (f32x4){0.f, 0.f, 0.f, 0.f}, lb1 = lb0;
                if (cgp == 1) { lb0 = *(const f32x4*)(LB + (c0 - 1024)); lb1 = *(const f32x4*)(LB + (c0 - 1024) + 4); }
#pragma unroll
                for (int ai = 0; ai < 2; ++ai)
#pragma unroll
                    for (int m = 0; m < 4; ++m) {
                        const int t = row0 + ai * HALF + m * 16 + PADM;
                        f32x4 v0 = acc[ai][bj][m][0], v1 = acc[ai][bj][m][1];
                        if (cgp == 0) {
#pragma unroll
                            for (int e = 0; e < 4; ++e) { v0[e] = silu_f(v0[e]) * 0.08838834764831845f; v1[e] = silu_f(v1[e]) * 0.08838834764831845f; }
                        } else if (cgp == 1) {
                            f32x4 l0, l1;
#pragma unroll
                            for (int e = 0; e < 4; ++e) {
                                const float f0 = lb0[e] + (1.0f - lb0[e]) * sigmoid_f(v0[e]), f1 = lb1[e] + (1.0f - lb1[e]) * sigmoid_f(v1[e]);
                                l0[e] = logf(f0); l1[e] = logf(f1); v0[e] = 1.0f - f0; v1[e] = 1.0f - f1;
                            }
                            float* lp = LOGF + (size_t)t * 1024 + (c0 - 1024);
                            *(f32x4*)lp = l0; *(f32x4*)(lp + 4) = l1;
                        } else if (cgp == 3 || cgp == 7) {
#pragma unroll
                            for (int e = 0; e < 4; ++e) { v0[e] = silu_f(v0[e]); v1[e] = silu_f(v1[e]); }
                        }
                        u32x4 w; w.x = cvt_pk_bf16(v0[0], v0[1]); w.y = cvt_pk_bf16(v0[2], v0[3]); w.z = cvt_pk_bf16(v1[0], v1[1]); w.w = cvt_pk_bf16(v1[2], v1[3]);
                        *(u32x4*)(PROJ + (size_t)t * NPROJ + c0) = w;
                    }
            }
        }
    }
};

struct EpiResid {
    static constexpr bool PERM = false, AFTER_DRAIN = false;
    const float* src; const float* st; const float* g; const float* b; float* out;
    __device__ __forceinline__ void operator()(const f32x4 (&acc)[2][2][4][2], const Unit& u, int wr, int wc, int fr, int fq) const {
        const int row0 = u.pm * BM + wr * 64 + fr, col0 = u.pn * BM + wc * 32 + 4 * fq;
        f32x4 gv[2][2], bv[2][2];
#pragma unroll
        for (int bj = 0; bj < 2; ++bj)
#pragma unroll
            for (int n = 0; n < 2; ++n) { gv[bj][n] = *(const f32x4*)(g + col0 + bj * HALF + n * 16); bv[bj][n] = *(const f32x4*)(b + col0 + bj * HALF + n * 16); }
#pragma unroll
        for (int ai = 0; ai < 2; ++ai)
#pragma unroll
            for (int m = 0; m < 4; ++m) {
                const int r = row0 + ai * HALF + m * 16; const float mu = st[2 * r], rstd = st[2 * r + 1];
                const size_t off = (size_t)r * DM + col0;
#pragma unroll
                for (int bj = 0; bj < 2; ++bj)
#pragma unroll
                    for (int n = 0; n < 2; ++n) {
                        const f32x4 xv = *(const f32x4*)(src + off + bj * HALF + n * 16);
                        const f32x4 hv = (xv - mu) * rstd * gv[bj][n] + bv[bj][n];
                        *(f32x4*)(out + off + bj * HALF + n * 16) = hv * ALPHA + acc[ai][bj][m][n];
                    }
            }
    }
};

struct EpiGU {
    static constexpr bool PERM = true, AFTER_DRAIN = false;
    bf16_t* ACT;
    __device__ __forceinline__ void operator()(const f32x4 (&acc)[2][2][4][2], const Unit& u, int wr, int wc, int fr, int fq) const {
        const int row0 = u.pm * BM + wr * 64 + fr, c0 = u.pn * HALF + wc * 32 + 8 * fq;
#pragma unroll
        for (int ai = 0; ai < 2; ++ai)
#pragma unroll
            for (int m = 0; m < 4; ++m) {
                const int r = row0 + ai * HALF + m * 16;
                f32x4 v0, v1;
#pragma unroll
                for (int e = 0; e < 4; ++e) { v0[e] = silu_f(acc[ai][0][m][0][e]) * acc[ai][1][m][0][e]; v1[e] = silu_f(acc[ai][0][m][1][e]) * acc[ai][1][m][1][e]; }
                u32x4 w; w.x = cvt_pk_bf16(v0[0], v0[1]); w.y = cvt_pk_bf16(v0[2], v0[3]); w.z = cvt_pk_bf16(v1[0], v1[1]); w.w = cvt_pk_bf16(v1[2], v1[3]);
                *(u32x4*)(ACT + (size_t)r * DFF + c0) = w;
            }
    }
};

template <class Epi, class Sched, bool ALIGN_EPI = false, bool SP2 = false>
__device__ __forceinline__ void gemm_phase(PG8_LAS unsigned char* lds, const Gemm g, const Sched& S, const Epi& E) {
    const int tid = threadIdx.x, wid = __builtin_amdgcn_readfirstlane(tid >> 6), lane = tid & 63, wr = wid >> 2, wc = wid & 3, fr = lane & 15, fq = lane >> 4;
    const int K = g.K, nt = K / BK;
    unsigned voffA[2], voffB[2];
#pragma unroll
    for (int i = 0; i < 2; ++i) { int R, C; stage_rc(tid * 16 + i * 8192, R, C); const int Rb = Epi::PERM ? ((R & ~31) + perm32(R & 31)) : R;
        voffA[i] = (unsigned)(R * K + C) * 2u; voffB[i] = (unsigned)(Rb * K + C) * 2u; }
    const size_t kstep = (size_t)(BK * 2);
    const size_t hstep = (size_t)HALF * K * 2;
    const size_t tstep = 2 * hstep;
    const unsigned ldsw = (unsigned)wid * 1024u;
    const int aoff = lds_byte(wr * 64 + fr, fq * 8), boff = lds_byte(wc * 32 + fr, fq * 8);
#define PG8_SA(b, h) (((b) * 2 + (h)) * HTB)
#define PG8_SB(b, h) ((4 + (b) * 2 + (h)) * HTB)
#define PG8_STAGE(bufoff, gbase, voff) do { _Pragma("unroll") for (int _i = 0; _i < 2; ++_i) \
        __builtin_amdgcn_global_load_lds((const unsigned*)((const char*)(gbase) + (voff)[_i]), (PG8_LAS unsigned*)(lds + (bufoff) + ldsw + _i * 8192), 16, 0, 0); } while (0)
#define PG8_LDA(dst, b, h) do { _Pragma("unroll") for (int m = 0; m < 4; ++m) _Pragma("unroll") for (int k = 0; k < 2; ++k) dst[m][k] = *(const PG8_LAS bf16x8*)(lds + PG8_SA(b, h) + aoff + m * 2048 + k * 1024); } while (0)
#define PG8_LDB(dst, b, h) do { _Pragma("unroll") for (int n = 0; n < 2; ++n) _Pragma("unroll") for (int k = 0; k < 2; ++k) dst[n][k] = *(const PG8_LAS bf16x8*)(lds + PG8_SB(b, h) + boff + n * 2048 + k * 1024); } while (0)
#define PG8_MMA(ai, bj, At, Bt) do { __builtin_amdgcn_s_setprio(1); _Pragma("unroll") for (int m = 0; m < 4; ++m) _Pragma("unroll") for (int n = 0; n < 2; ++n) _Pragma("unroll") for (int k = 0; k < 2; ++k) \
        acc[ai][bj][m][n] = __builtin_amdgcn_mfma_f32_16x16x32_bf16(Bt[n][k], At[m][k], acc[ai][bj][m][n], 0, 0, 0); __builtin_amdgcn_s_setprio(0); } while (0)
#define PG8_WAIT_V(n) asm volatile("s_waitcnt vmcnt(" #n ")" ::: "memory")
#define PG8_WAIT_L(n) asm volatile("s_waitcnt lgkmcnt(" #n ")" ::: "memory")
#define PG8_BAR __builtin_amdgcn_s_barrier()
#define PG8_SCHED __builtin_amdgcn_sched_barrier(0)
    Unit cur, nxt; int ui = 0;
    if (!S.next(0, cur)) return;
    f32x4 acc[2][2][4][2];
#pragma unroll
    for (int a = 0; a < 2; ++a)
#pragma unroll
        for (int b = 0; b < 2; ++b)
#pragma unroll
            for (int m = 0; m < 4; ++m)
#pragma unroll
                for (int n = 0; n < 2; ++n) acc[a][b][m][n] = (f32x4){0.f, 0.f, 0.f, 0.f};
    bf16x8 At[4][2], B0[2][2], B1[2][2];
    const char* cA = (const char*)g.A + (size_t)cur.pm * tstep; const char* cB = (const char*)g.Bt + (size_t)cur.pn * tstep;
    S.a_ready(cur);
    if constexpr (SP2) {
        PG8_STAGE(PG8_SB(0, 0), cB, voffB); PG8_STAGE(PG8_SB(0, 1), cB + hstep, voffB); PG8_STAGE(PG8_SA(0, 0), cA, voffA); PG8_STAGE(PG8_SA(0, 1), cA + hstep, voffA);
        if (wr == 1) PG8_BAR;
        PG8_WAIT_V(2); PG8_BAR;
        PG8_STAGE(PG8_SB(1, 0), cB + kstep, voffB); PG8_STAGE(PG8_SA(1, 0), cA + kstep, voffA); PG8_STAGE(PG8_SB(1, 1), cB + hstep + kstep, voffB);
        PG8_WAIT_V(6); PG8_BAR;
    } else {
        PG8_STAGE(PG8_SB(0, 0), cB, voffB); PG8_STAGE(PG8_SA(0, 0), cA, voffA); PG8_STAGE(PG8_SB(0, 1), cB + hstep, voffB); PG8_STAGE(PG8_SA(0, 1), cA + hstep, voffA);
        if (wr == 1) PG8_BAR;
        PG8_WAIT_V(4); PG8_BAR;
        PG8_STAGE(PG8_SB(1, 0), cB + kstep, voffB); PG8_STAGE(PG8_SA(1, 0), cA + kstep, voffA); PG8_STAGE(PG8_SB(1, 1), cB + hstep + kstep, voffB);
        PG8_WAIT_V(6); PG8_BAR;
    }
    for (;;) {
        const bool has_next = S.next(ui + 1, nxt);
        const char* nA = has_next ? (const char*)g.A + (size_t)nxt.pm * tstep : cA; const char* nB = has_next ? (const char*)g.Bt + (size_t)nxt.pn * tstep : cB;
        for (int t = 0; t < nt; t += 2) {
            const bool last = (t == nt - 2);
            const char* a1 = cA + (size_t)(t + 1) * kstep;
            const char* a2 = last ? nA : cA + (size_t)(t + 2) * kstep; const char* b2 = last ? nB : cB + (size_t)(t + 2) * kstep;
            const char* a3 = a2 + kstep; const char* b3 = b2 + kstep;
            if (last && has_next) S.a_ready(nxt);
            if constexpr (SP2) {
            PG8_LDB(B0, 0, 0); PG8_LDB(B1, 0, 1); PG8_SCHED; PG8_LDA(At, 0, 0); PG8_STAGE(PG8_SA(1, 1), a1 + hstep, voffA);
            PG8_WAIT_V(8); PG8_WAIT_L(0); PG8_BAR; PG8_MMA(0, 0, At, B0); PG8_MMA(0, 1, At, B1); PG8_BAR; PG8_SCHED;
            PG8_LDA(At, 0, 1); PG8_STAGE(PG8_SB(0, 0), b2, voffB); PG8_STAGE(PG8_SB(0, 1), b2 + hstep, voffB); PG8_STAGE(PG8_SA(0, 0), a2, voffA);
            PG8_WAIT_V(8); PG8_WAIT_L(0); PG8_BAR; PG8_MMA(1, 0, At, B0); PG8_MMA(1, 1, At, B1); PG8_BAR; PG8_SCHED;
            PG8_LDB(B0, 1, 0); PG8_LDB(B1, 1, 1); PG8_SCHED; PG8_LDA(At, 1, 0); PG8_STAGE(PG8_SA(0, 1), a2 + hstep, voffA);
            PG8_WAIT_V(8); PG8_WAIT_L(0); PG8_BAR; PG8_MMA(0, 0, At, B0); PG8_MMA(0, 1, At, B1); PG8_BAR; PG8_SCHED;
            PG8_LDA(At, 1, 1); PG8_STAGE(PG8_SB(1, 0), b3, voffB); PG8_STAGE(PG8_SB(1, 1), b3 + hstep, voffB); PG8_STAGE(PG8_SA(1, 0), a3, voffA);
            PG8_WAIT_V(8); PG8_WAIT_L(0); PG8_BAR; PG8_MMA(1, 0, At, B0); PG8_MMA(1, 1, At, B1); PG8_BAR; PG8_SCHED;
            } else {
            PG8_LDB(B0, 0, 0); PG8_SCHED; PG8_LDA(At, 0, 0); PG8_STAGE(PG8_SA(1, 1), a1 + hstep, voffA);
            PG8_WAIT_L(8); PG8_BAR; PG8_WAIT_L(0); PG8_MMA(0, 0, At, B0); PG8_BAR; PG8_SCHED;
            PG8_LDB(B1, 0, 1); PG8_STAGE(PG8_SB(0, 0), b2, voffB);
            PG8_BAR; PG8_WAIT_L(0); PG8_MMA(0, 1, At, B1); PG8_BAR;
            PG8_LDA(At, 0, 1); PG8_STAGE(PG8_SA(0, 0), a2, voffA);
            PG8_BAR; PG8_WAIT_L(0); PG8_MMA(1, 0, At, B0); PG8_BAR; PG8_SCHED;
            PG8_STAGE(PG8_SB(0, 1), b2 + hstep, voffB);
            PG8_WAIT_V(6); PG8_BAR; PG8_MMA(1, 1, At, B1); PG8_BAR;
            PG8_LDB(B0, 1, 0); PG8_SCHED; PG8_LDA(At, 1, 0); PG8_STAGE(PG8_SA(0, 1), a2 + hstep, voffA);
            PG8_WAIT_L(8); PG8_BAR; PG8_WAIT_L(0); PG8_MMA(0, 0, At, B0); PG8_BAR; PG8_SCHED;
            PG8_LDB(B1, 1, 1); PG8_STAGE(PG8_SB(1, 0), b3, voffB);
            PG8_BAR; PG8_WAIT_L(0); PG8_MMA(0, 1, At, B1); PG8_BAR;
            PG8_LDA(At, 1, 1); PG8_STAGE(PG8_SA(1, 0), a3, voffA);
            PG8_BAR; PG8_WAIT_L(0); PG8_MMA(1, 0, At, B0); PG8_BAR; PG8_SCHED;
            PG8_STAGE(PG8_SB(1, 1), b3 + hstep, voffB);
            PG8_WAIT_V(6); PG8_BAR; PG8_MMA(1, 1, At, B1); PG8_BAR;
            }
        }
        if constexpr (ALIGN_EPI) { if (wr == 0) PG8_BAR; }
        if constexpr (!Epi::AFTER_DRAIN) { E(acc, cur, wr, wc, fr, fq); S.done(cur); }
        if (!has_next) break;
#pragma unroll
        for (int a = 0; a < 2; ++a)
#pragma unroll
            for (int b = 0; b < 2; ++b)
#pragma unroll
                for (int m = 0; m < 4; ++m)
#pragma unroll
                    for (int n = 0; n < 2; ++n) acc[a][b][m][n] = (f32x4){0.f, 0.f, 0.f, 0.f};
        cur = nxt; cA = nA; cB = nB; ++ui;
        if constexpr (ALIGN_EPI) { if (wr == 1) PG8_BAR; }
    }
    PG8_WAIT_V(0);
    if constexpr (!ALIGN_EPI) { if (wr == 0) PG8_BAR; }
    PG8_BAR;
    if constexpr (Epi::AFTER_DRAIN) { E.fused(acc, cur, wr, wc, fr, fq, lds, wid, lane); S.done(cur); }
#undef PG8_SA
#undef PG8_SB
#undef PG8_STAGE
#undef PG8_LDA
#undef PG8_LDB
#undef PG8_MMA
#undef PG8_WAIT_V
#undef PG8_WAIT_L
#undef PG8_BAR
#undef PG8_SCHED
}
}

constexpr int NWAVES = 8;
constexpr int DM = 2048, SEQ = 8192, LT = 8256, NPROJ = 8192, DFF = 5632, PADM = 64  , PADF = 48, NCHUNK = LT / 64;
constexpr size_t MiB = 1u << 20;
constexpr size_t WS_CTL = 0, CTL_ZERO_BYTES = 64 * 1024;
constexpr size_t WS_LB = 1 * MiB;
constexpr size_t WS_ST0 = 1 * MiB + 64 * 1024;
constexpr size_t WS_ST1 = 1 * MiB + 192 * 1024;
constexpr size_t WS_HM = 1 * MiB + 320 * 1024;
constexpr size_t WS_WIN = 2 * MiB;
constexpr size_t WS_WOUT = 2 * MiB;
constexpr size_t WS_WDOWN = 10 * MiB;
constexpr size_t WS_H0B = 34 * MiB;
constexpr size_t WS_MIX = 34 * MiB;
constexpr size_t WS_H1B = 34 * MiB;
constexpr size_t WS_PROJ = 66 * MiB;
constexpr size_t WS_Z = 66 * MiB;
constexpr size_t WS_ACT = 130 * MiB;
constexpr size_t WS_LOGF = 195 * MiB;
constexpr size_t WS_WGU = 228 * MiB;
constexpr size_t WS_END = 272 * MiB;
static_assert(WS_PROJ + (size_t)LT * NPROJ * 2 <= WS_LOGF && WS_LOGF + (size_t)LT * 1024 * 4 <= WS_WGU && WS_WGU + (size_t)2 * DFF * DM * 2 <= WS_END, "ws map");
static_assert(WS_ACT + (size_t)SEQ * DFF * 2 <= WS_WGU && WS_Z + (size_t)SEQ * DM * 4 <= WS_ACT && WS_WDOWN + (size_t)DM * DFF * 2 <= WS_H0B, "ws map 2");
constexpr size_t DO_RC = 0, DO_RS = (size_t)LT * 128 * 4;
constexpr int CW_BAR = 1024;
constexpr int RING_OFF = 0, RING_BYTES = 131072, LDSCTL_OFF = RING_BYTES, MISC_OFF = LDSCTL_OFF + 320, LDS_BYTES = 147456;

#define GAS __attribute__((address_space(1)))
#define LAS __attribute__((address_space(3)))
typedef unsigned short bf16;
typedef unsigned v4u __attribute__((ext_vector_type(4)));
typedef unsigned v2u __attribute__((ext_vector_type(2)));
typedef float f32x4 __attribute__((ext_vector_type(4)));
typedef short bf16x8 __attribute__((ext_vector_type(8)));
typedef short bf16x4 __attribute__((ext_vector_type(4)));
typedef GAS unsigned gu32;
#define RLX_AGENT __ATOMIC_RELAXED, __HIP_MEMORY_SCOPE_AGENT
#define LDS_WAIT() asm volatile("s_waitcnt lgkmcnt(0)" ::: "memory")
__device__ __forceinline__ float bf2f(bf16 v) { return __uint_as_float((unsigned)v << 16); }
__device__ __forceinline__ unsigned f2bf(float f) { unsigned u = __builtin_bit_cast(unsigned, f); return (u + 0x7fffu + ((u >> 16) & 1u)) >> 16; }
__device__ __forceinline__ unsigned pk2(float lo, float hi) { return f2bf(lo) | (f2bf(hi) << 16); }
using pg8::fexp; using pg8::silu_f; using pg8::sigmoid_f;

#define XB_TMO      128
#define XB_XCNT(j)  (256  + 64 * (j))
#define XB_XSUB(j)  (1280 + 64 * (j))
#define XB_XGEN(j)  (2304 + 64 * (j))
#define XB_TOP      3328
#define XB_TOPGEN   3392
#define XCD_BAR_WORDS 3456
#define XB_SPIN_CAP (1u << 18)

__device__ __forceinline__ unsigned xb_ld(unsigned* p)              { return __hip_atomic_load(p, __ATOMIC_RELAXED, __HIP_MEMORY_SCOPE_AGENT); }
__device__ __forceinline__ unsigned xb_add(unsigned* p, unsigned v) { return __hip_atomic_fetch_add(p, v, __ATOMIC_RELAXED, __HIP_MEMORY_SCOPE_AGENT); }
__device__ __forceinline__ unsigned xb_xcc_id() { return (unsigned)__builtin_amdgcn_s_getreg((3 << 11) | 20) & 0xFu; }
#define XB_SPIN(cond, bar) do { unsigned _sp = 0; while (cond) { __builtin_amdgcn_s_sleep(1); \
    if ((++_sp & 255u) == 0u) { if (xb_ld(&(bar)[XB_TMO])) break; if (_sp > XB_SPIN_CAP) { atomicAdd(&(bar)[XB_TMO], 1u); break; } } } } while (0)

struct XcdBarrier {
    unsigned* bar; unsigned x;
    volatile LAS unsigned* st;
};

__device__ __forceinline__ XcdBarrier xcd_barrier_post(unsigned* bar, volatile LAS unsigned* st) {
    XcdBarrier b; b.bar = bar; b.x = xb_xcc_id(); b.st = st;
    if (threadIdx.x == 0) (void)xb_add(&bar[XB_XCNT(b.x)], 1u);
    return b;
}
__device__ __forceinline__ void xcd_barrier_complete(unsigned* bar, unsigned x, unsigned& nloc, unsigned& nx) {
    const unsigned G = gridDim.x * gridDim.y * gridDim.z;
    unsigned sum, cnt, mine, sp = 0u;
    for (;;) {
        sum = 0u; cnt = 0u; mine = 0u;
#pragma unroll
        for (unsigned j = 0; j < 16; ++j) { const unsigned c = xb_ld(&bar[XB_XCNT(j)]); sum += c; cnt += (c > 0u) ? 1u : 0u; mine = (j == x) ? c : mine; }
        if (sum == G) break;
        __builtin_amdgcn_s_sleep(1);
        if ((++sp & 255u) == 0u) { if (xb_ld(&bar[XB_TMO])) break; if (sp > XB_SPIN_CAP) { atomicAdd(&bar[XB_TMO], 1u); break; } }
    }
    nloc = mine > 0u ? mine : 1u; nx = cnt > 0u ? cnt : 1u;
}

__device__ __forceinline__ void xcd_barrier(const XcdBarrier& b) {
    asm volatile("s_waitcnt vmcnt(0)" ::: "memory");
    __syncthreads();
    if (threadIdx.x == 0) {
        unsigned* bar = b.bar;
        __builtin_amdgcn_s_waitcnt(0);
        unsigned nloc = b.st[0], nx = b.st[1];
        if (nloc == 0u) { xcd_barrier_complete(bar, b.x, nloc, nx); b.st[0] = nloc; b.st[1] = nx; }
        const unsigned old = xb_add(&bar[XB_XSUB(b.x)], 1u);
        const unsigned gen = old / nloc;
        if (old + 1u == (gen + 1u) * nloc) {
            __builtin_amdgcn_fence(__ATOMIC_RELEASE, "agent");
            asm volatile("s_waitcnt vmcnt(0)" ::: "memory");
            const unsigned og = xb_add(&bar[XB_TOP], 1u);
            const unsigned tg = og / nx;
            if (og + 1u == (tg + 1u) * nx) xb_add(&bar[XB_TOPGEN], 1u);
            else XB_SPIN(xb_ld(&bar[XB_TOPGEN]) == tg, bar);
            __builtin_amdgcn_fence(__ATOMIC_ACQUIRE, "agent");
            xb_add(&bar[XB_XGEN(b.x)], 1u);
            asm volatile("s_waitcnt vmcnt(0)" ::: "memory");
        } else {
            XB_SPIN(xb_ld(&bar[XB_XGEN(b.x)]) == gen, bar);
            __builtin_amdgcn_fence(__ATOMIC_ACQUIRE, "agent");
            asm volatile("s_waitcnt vmcnt(0)" ::: "memory");
        }
    }
    __syncthreads();
}

struct Frame {
    LAS unsigned char* lds;
    volatile LAS unsigned* MISC;
    int tid, lane, wave, G;
    const float *x, *meta, *ln_in_g, *ln_in_b, *hlb, *w_in, *hg_ng, *ret_ng, *ret_nb, *w_out, *ln1_g, *ln1_b, *w_gate, *w_up, *w_down, *ln2_g, *ln2_b;
    float* out; unsigned char* ws;
};
__device__ __forceinline__ float wave_sum(float v) {
#pragma unroll
    for (int o = 1; o < 64; o <<= 1) v += __shfl_xor(v, o);
    return v;
}
template <int MAP> __device__ __forceinline__ void transpose_item(const float* W, int K, int N, bf16* WT, LAS float* scr, int item, int lane) {
    const int nblk = N / 32, kb = item / nblk, nb = item % nblk, k0 = 64 * kb, n0 = 32 * nb;
    const int rbase = (MAP == 0) ? n0 : (256 * (n0 >> 7) + (n0 & 127) + (MAP == 2 ? 128 : 0));
#pragma unroll 8
    for (int i = 0; i < 32; ++i) { const int kk = 2 * i + (lane >> 5); scr[kk * 33 + (lane & 31)] = W[(size_t)(k0 + kk) * N + n0 + (lane & 31)]; }
    LDS_WAIT(); asm volatile("" ::: "memory");
    const int c = lane & 7;
#pragma unroll
    for (int j = 0; j < 4; ++j) { const int n = (lane >> 3) + 8 * j; const LAS float* s = scr + (8 * c) * 33 + n;
        v4u o; o.x = pk2(s[0 * 33], s[1 * 33]); o.y = pk2(s[2 * 33], s[3 * 33]); o.z = pk2(s[4 * 33], s[5 * 33]); o.w = pk2(s[6 * 33], s[7 * 33]);
        *(GAS v4u*)(WT + (size_t)(rbase + n) * K + k0 + 8 * c) = o; }
    LDS_WAIT(); asm volatile("" ::: "memory");
}
__device__ __forceinline__ void ln_row(const float* xrow, bool zero_in, const float* g, const float* b, bf16* ob, float* of, float* st, int lane) {
    const GAS f32x4* xr = (const GAS f32x4*)xrow + lane;
    f32x4 v[8]; float s = 0.f;
#pragma unroll
    for (int j = 0; j < 8; ++j) { v[j] = zero_in ? (f32x4){0.f, 0.f, 0.f, 0.f} : xr[64 * j]; s += (v[j].x + v[j].y) + (v[j].z + v[j].w); }
    const float mean = wave_sum(s) * (1.f / DM); float s2 = 0.f;
#pragma unroll
    for (int j = 0; j < 8; ++j) { v[j] = v[j] - mean; s2 += (v[j].x * v[j].x + v[j].y * v[j].y) + (v[j].z * v[j].z + v[j].w * v[j].w); }
    const float rstd = 1.f / sqrtf(wave_sum(s2) * (1.f / DM) + 1e-5f);
#pragma unroll
    for (int j = 0; j < 8; ++j) {
        const f32x4 gv = *((const GAS f32x4*)g + lane + 64 * j), bv = *((const GAS f32x4*)b + lane + 64 * j);
        const f32x4 y = v[j] * rstd * gv + bv;
        if (ob) *((GAS v2u*)ob + lane + 64 * j) = (v2u){pk2(y.x, y.y), pk2(y.z, y.w)};
        if (of) *((GAS f32x4*)of + lane + 64 * j) = y;
    }
    if (st && lane == 0) { st[0] = mean; st[1] = rstd; }
}

__device__ __forceinline__ bf16x8 tr_read2(unsigned a_lo, unsigned a_hi) {
    bf16x4 lo, hi;
    asm volatile("ds_read_b64_tr_b16 %0, %2\n\tds_read_b64_tr_b16 %1, %3\n\ts_waitcnt lgkmcnt(0)" : "=&v"(lo), "=&v"(hi) : "v"(a_lo), "v"(a_hi) : "memory");
    bf16x8 r; r[0] = lo[0]; r[1] = lo[1]; r[2] = lo[2]; r[3] = lo[3]; r[4] = hi[0]; r[5] = hi[1]; r[6] = hi[2]; r[7] = hi[3]; return r;
}
#define MFMA16(a, b, c) __builtin_amdgcn_mfma_f32_16x16x32_bf16((a), (b), (c), 0, 0, 0)

constexpr int HQS = 272, HTS = 144, HVS = 80;
constexpr int H_QD = 0, H_KD = H_QD + 64 * HQS, H_KDT = H_KD + 64 * HQS, H_V = H_KDT + 128 * HTS, H_SB = H_V + 64 * HVS, H_EL = H_SB + 32 * HQS, H_TOT = H_EL + 512, H_END = H_TOT + 2048;
static_assert(H_END <= RING_BYTES, "hgrn lds");
__device__ __forceinline__ void hgrn_scan(LAS unsigned char* lds, const bf16* __restrict__ PROJ, const float* __restrict__ LOGF, float* __restrict__ HGO, int h, int j) {
    const int tid = threadIdx.x, lane = tid & 63, w = __builtin_amdgcn_readfirstlane(tid >> 6);
    const int r16 = lane & 15, q4 = lane >> 4, tq = w >> 1, vh = w & 1;
    const int a_ = (lane & 15) >> 2, p_ = lane & 3;
    const int kk = tid & 127, g = tid >> 7;
    const unsigned lbase = (unsigned)(size_t)lds;
    f32x4 S[2]; S[0] = (f32x4){0.f, 0.f, 0.f, 0.f}; S[1] = S[0];
    for (int i = tid; i < 32 * HQS / 4; i += 512) ((LAS unsigned*)(lds + H_SB))[i] = 0u;
    __syncthreads();
    for (int c = 0; c < NCHUNK; ++c) {
        const int t0 = c * 64;
        float cs[16]; float run = 0.f;
#pragma unroll
        for (int i = 0; i < 16; ++i) { run += LOGF[(size_t)(t0 + 16 * g + i) * 1024 + h * 128 + kk]; cs[i] = run; }
        ((LAS float*)(lds + H_TOT))[g * 128 + kk] = run;
        __syncthreads();
        float off = 0.f, last = 0.f;
#pragma unroll
        for (int gg = 0; gg < 4; ++gg) { const float tv = ((LAS float*)(lds + H_TOT))[gg * 128 + kk]; last += tv; if (gg < g) off += tv; }
        unsigned kdt[8];
#pragma unroll
        for (int i = 0; i < 16; i += 2) {
            float qv[2], kv[2];
#pragma unroll
            for (int e = 0; e < 2; ++e) {
                const int t = t0 + 16 * g + i + e; const float cum = off + cs[i + e];
                qv[e] = bf2f(PROJ[(size_t)t * NPROJ + h * 128 + kk]) * fexp(cum);
                kv[e] = bf2f(PROJ[(size_t)t * NPROJ + 1024 + h * 128 + kk]) * fexp(-cum);
                *(LAS bf16*)(lds + H_QD + (16 * g + i + e) * HQS + kk * 2) = (bf16)f2bf(qv[e]);
                *(LAS bf16*)(lds + H_KD + (16 * g + i + e) * HQS + kk * 2) = (bf16)f2bf(kv[e]);
            }
            kdt[i >> 1] = pk2(kv[0], kv[1]);
        }
        *(LAS v4u*)(lds + H_KDT + kk * HTS + 32 * g) = (v4u){kdt[0], kdt[1], kdt[2], kdt[3]};
        *(LAS v4u*)(lds + H_KDT + kk * HTS + 32 * g + 16) = (v4u){kdt[4], kdt[5], kdt[6], kdt[7]};
        if (g == 0) ((LAS float*)(lds + H_EL))[kk] = fexp(last);
        { const int s = tid >> 3, vq = tid & 7;
          *(LAS v2u*)(lds + H_V + s * HVS + vq * 8) = *(const v2u*)(PROJ + (size_t)(t0 + s) * NPROJ + 2048 + h * 128 + 32 * j + 4 * vq); }
        __syncthreads();
        f32x4 o = (f32x4){0.f, 0.f, 0.f, 0.f};
#pragma unroll
        for (int kb = 0; kb < 4; ++kb) {
            const bf16x8 a = *(const LAS bf16x8*)(lds + H_QD + (16 * tq + r16) * HQS + (32 * kb + 8 * q4) * 2);
            const bf16x8 b = *(const LAS bf16x8*)(lds + H_SB + (16 * vh + r16) * HQS + (32 * kb + 8 * q4) * 2);
            o = MFMA16(a, b, o);
        }
#pragma unroll
        for (int p = 0; p < 2; ++p) {
            if (2 * p <= tq) {
                f32x4 xa = (f32x4){0.f, 0.f, 0.f, 0.f}, xb = xa;
#pragma unroll
                for (int kb = 0; kb < 4; ++kb) {
                    const bf16x8 a = *(const LAS bf16x8*)(lds + H_KD + (32 * p + r16) * HQS + (32 * kb + 8 * q4) * 2);
                    const bf16x8 b = *(const LAS bf16x8*)(lds + H_QD + (16 * tq + r16) * HQS + (32 * kb + 8 * q4) * 2);
                    xa = MFMA16(a, b, xa);
                }
                if (2 * p == tq) {
#pragma unroll
                    for (int i = 0; i < 4; ++i) if (4 * q4 + i > r16) xa[i] = 0.f;
                }
                if (2 * p + 1 <= tq) {
#pragma unroll
                    for (int kb = 0; kb < 4; ++kb) {
                        const bf16x8 a = *(const LAS bf16x8*)(lds + H_KD + (32 * p + 16 + r16) * HQS + (32 * kb + 8 * q4) * 2);
                        const bf16x8 b = *(const LAS bf16x8*)(lds + H_QD + (16 * tq + r16) * HQS + (32 * kb + 8 * q4) * 2);
                        xb = MFMA16(a, b, xb);
                    }
                    if (2 * p + 1 == tq) {
#pragma unroll
                        for (int i = 0; i < 4; ++i) if (4 * q4 + i > r16) xb[i] = 0.f;
                    }
                }
                bf16x8 pa;
                pa[0] = (short)f2bf(xa[0]); pa[1] = (short)f2bf(xa[1]); pa[2] = (short)f2bf(xa[2]); pa[3] = (short)f2bf(xa[3]);
                pa[4] = (short)f2bf(xb[0]); pa[5] = (short)f2bf(xb[1]); pa[6] = (short)f2bf(xb[2]); pa[7] = (short)f2bf(xb[3]);
                const unsigned va = lbase + H_V + (32 * p + 4 * q4 + a_) * HVS + (16 * vh + 4 * p_) * 2;
                const bf16x8 vb = tr_read2(va, va + 16 * HVS);
                o = MFMA16(pa, vb, o);
            }
        }
        if (c > 0) {
#pragma unroll
            for (int i = 0; i < 4; ++i) HGO[(size_t)(t0 - PADM + 16 * tq + 4 * q4 + i) * 1024 + h * 128 + 32 * j + 16 * vh + r16] = o[i];
        }
#pragma unroll
        for (int u = 0; u < 2; ++u) {
            const int kt = 2 * (w >> 1) + u;
#pragma unroll
            for (int sb = 0; sb < 2; ++sb) {
                const bf16x8 a = *(const LAS bf16x8*)(lds + H_KDT + (16 * kt + r16) * HTS + (32 * sb + 8 * q4) * 2);
                const unsigned va = lbase + H_V + (32 * sb + 8 * q4 + a_) * HVS + (16 * vh + 4 * p_) * 2;
                const bf16x8 vb = tr_read2(va, va + 4 * HVS);
                S[u] = MFMA16(a, vb, S[u]);
            }
#pragma unroll
            for (int i = 0; i < 4; ++i) S[u][i] *= ((const LAS float*)(lds + H_EL))[16 * kt + 4 * q4 + i];
        }
        __syncthreads();
#pragma unroll
        for (int u = 0; u < 2; ++u) {
            const int kt = 2 * (w >> 1) + u;
            *(LAS v2u*)(lds + H_SB + (16 * vh + r16) * HQS + (16 * kt + 4 * q4) * 2) = (v2u){pk2(S[u][0], S[u][1]), pk2(S[u][2], S[u][3])};
        }
    }
    __syncthreads();
}

constexpr int RQS = 528, RVS = 80;
constexpr int R_Q = 0, R_K = R_Q + 64 * RQS, R_V = R_K + 64 * RQS, R_VD = R_V + 64 * RVS, R_RB = R_VD + 64 * RVS, R_END = R_RB + 32 * RQS;
static_assert(R_END <= RING_BYTES, "ret lds");
__device__ __forceinline__ void ret_scan(LAS unsigned char* lds, const bf16* __restrict__ PROJ, float* __restrict__ RETO, int h, int j) {
    const int tid = threadIdx.x, lane = tid & 63, w = __builtin_amdgcn_readfirstlane(tid >> 6);
    const int r16 = lane & 15, q4 = lane >> 4, tq = w >> 1, vh = w & 1;
    const int a_ = (lane & 15) >> 2, p_ = lane & 3;
    const unsigned lbase = (unsigned)(size_t)lds;
    const float l2g = log2f(1.0f - exp2f(-5.0f - (float)h));
    const float g64 = __builtin_amdgcn_exp2f(64.0f * l2g);
    f32x4 R[4];
#pragma unroll
    for (int u = 0; u < 4; ++u) R[u] = (f32x4){0.f, 0.f, 0.f, 0.f};
    for (int i = tid; i < 32 * RQS / 4; i += 512) ((LAS unsigned*)(lds + R_RB))[i] = 0u;
    __syncthreads();
    for (int c = 0; c < NCHUNK; ++c) {
        const int t0 = c * 64;
#pragma unroll
        for (int i = 0; i < 4; ++i) {
            const int id = tid + 512 * i, row = id >> 5, ch = id & 31;
            *(LAS v4u*)(lds + R_Q + row * RQS + ch * 16) = *(const v4u*)(PROJ + (size_t)(t0 + row) * NPROJ + 4096 + h * 256 + ch * 8);
            *(LAS v4u*)(lds + R_K + row * RQS + ch * 16) = *(const v4u*)(PROJ + (size_t)(t0 + row) * NPROJ + 5120 + h * 256 + ch * 8);
        }
        { const int s = tid >> 3, vq = tid & 7;
          const v2u raw = *(const v2u*)(PROJ + (size_t)(t0 + s) * NPROJ + 6144 + h * 256 + 32 * j + 4 * vq);
          *(LAS v2u*)(lds + R_V + s * RVS + vq * 8) = raw;
          const float dec = __builtin_amdgcn_exp2f((float)(63 - s) * l2g);
          const float v0 = __uint_as_float(raw.x << 16) * dec, v1 = __uint_as_float(raw.x & 0xffff0000u) * dec, v2 = __uint_as_float(raw.y << 16) * dec, v3 = __uint_as_float(raw.y & 0xffff0000u) * dec;
          *(LAS v2u*)(lds + R_VD + s * RVS + vq * 8) = (v2u){pk2(v0, v1), pk2(v2, v3)}; }
        __syncthreads();
        f32x4 o = (f32x4){0.f, 0.f, 0.f, 0.f};
#pragma unroll
        for (int kb = 0; kb < 8; ++kb) {
            const bf16x8 a = *(const LAS bf16x8*)(lds + R_Q + (16 * tq + r16) * RQS + (32 * kb + 8 * q4) * 2);
            const bf16x8 b = *(const LAS bf16x8*)(lds + R_RB + (16 * vh + r16) * RQS + (32 * kb + 8 * q4) * 2);
            o = MFMA16(a, b, o);
        }
#pragma unroll
        for (int i = 0; i < 4; ++i) o[i] *= __builtin_amdgcn_exp2f((float)(16 * tq + 4 * q4 + i + 1) * l2g);
#pragma unroll
        for (int p = 0; p < 2; ++p) {
            if (2 * p <= tq) {
                f32x4 xa = (f32x4){0.f, 0.f, 0.f, 0.f}, xb = xa;
#pragma unroll
                for (int kb = 0; kb < 8; ++kb) {
                    const bf16x8 a = *(const LAS bf16x8*)(lds + R_K + (32 * p + r16) * RQS + (32 * kb + 8 * q4) * 2);
                    const bf16x8 b = *(const LAS bf16x8*)(lds + R_Q + (16 * tq + r16) * RQS + (32 * kb + 8 * q4) * 2);
                    xa = MFMA16(a, b, xa);
                }
#pragma unroll
                for (int i = 0; i < 4; ++i) { const int rel = (16 * tq + r16) - (32 * p + 4 * q4 + i); xa[i] = rel >= 0 ? xa[i] * __builtin_amdgcn_exp2f((float)rel * l2g) : 0.f; }
                if (2 * p + 1 <= tq) {
#pragma unroll
                    for (int kb = 0; kb < 8; ++kb) {
                        const bf16x8 a = *(const LAS bf16x8*)(lds + R_K + (32 * p + 16 + r16) * RQS + (32 * kb + 8 * q4) * 2);
                        const bf16x8 b = *(const LAS bf16x8*)(lds + R_Q + (16 * tq + r16) * RQS + (32 * kb + 8 * q4) * 2);
                        xb = MFMA16(a, b, xb);
                    }
#pragma unroll
                    for (int i = 0; i < 4; ++i) { const int rel = (16 * tq + r16) - (32 * p + 16 + 4 * q4 + i); xb[i] = rel >= 0 ? xb[i] * __builtin_amdgcn_exp2f((float)rel * l2g) : 0.f; }
                }
                bf16x8 pa;
                pa[0] = (short)f2bf(xa[0]); pa[1] = (short)f2bf(xa[1]); pa[2] = (short)f2bf(xa[2]); pa[3] = (short)f2bf(xa[3]);
                pa[4] = (short)f2bf(xb[0]); pa[5] = (short)f2bf(xb[1]); pa[6] = (short)f2bf(xb[2]); pa[7] = (short)f2bf(xb[3]);
                const unsigned va = lbase + R_V + (32 * p + 4 * q4 + a_) * RVS + (16 * vh + 4 * p_) * 2;
                const bf16x8 vb = tr_read2(va, va + 16 * RVS);
                o = MFMA16(pa, vb, o);
            }
        }
        if (c > 0) {
#pragma unroll
            for (int i = 0; i < 4; ++i) RETO[(size_t)(t0 - PADM + 16 * tq + 4 * q4 + i) * 1024 + h * 256 + 32 * j + 16 * vh + r16] = o[i];
        }
#pragma unroll
        for (int u = 0; u < 4; ++u) {
            const int kt = 4 * (w >> 1) + u;
#pragma unroll
            for (int i = 0; i < 4; ++i) R[u][i] *= g64;
#pragma unroll
            for (int sb = 0; sb < 2; ++sb) {
                const unsigned ka = lbase + R_K + (32 * sb + 8 * q4 + a_) * RQS + (16 * kt + 4 * p_) * 2;
                const bf16x8 a = tr_read2(ka, ka + 4 * RQS);
                const unsigned va = lbase + R_VD + (32 * sb + 8 * q4 + a_) * RVS + (16 * vh + 4 * p_) * 2;
                const bf16x8 vb = tr_read2(va, va + 4 * RVS);
                R[u] = MFMA16(a, vb, R[u]);
            }
        }
        __syncthreads();
#pragma unroll
        for (int u = 0; u < 4; ++u) {
            const int kt = 4 * (w >> 1) + u;
            *(LAS v2u*)(lds + R_RB + (16 * vh + r16) * RQS + (16 * kt + 4 * q4) * 2) = (v2u){pk2(R[u][0], R[u][1]), pk2(R[u][2], R[u][3])};
        }
    }
    __syncthreads();
}

__device__ __forceinline__ void meta_proj(Frame& F, const bf16* __restrict__ WINT, const bf16* __restrict__ HM, bf16* PROJ, float* LOGF, const float* LB, const float* RC, const float* RS) {
    LAS unsigned char* hm = F.lds;
    for (int i = F.tid; i < 16 * 2048 * 2 / 16; i += 512) *(LAS v4u*)(hm + 16 * i) = *((const v4u*)HM + i);
    __syncthreads();
    const int r = F.tid >> 5, ci = F.tid & 31, t = PADF + r;
    for (int grp = blockIdx.x; grp < 256; grp += F.G) {
        int col; int mode;
        if (grp < 128) { col = 32 * grp + ci; mode = col >> 10; }
        else if (grp < 192) { const int g2 = grp - 128, region = g2 >> 3, jj = g2 & 7; col = 4096 + region * 256 + 16 * jj + (ci & 15) + 128 * (ci >> 4); mode = 4 + (region >> 2); }
        else { col = 6144 + 32 * (grp - 192) + ci; mode = col >> 10; }
        const v4u* wrow = (const v4u*)(WINT + (size_t)col * DM);
        float acc = 0.f;
#pragma unroll 4
        for (int k8 = 0; k8 < 256; ++k8) {
            const v4u wv = wrow[k8]; const v4u hv = *(const LAS v4u*)(hm + r * 4096 + 16 * k8);
#pragma unroll
            for (int e = 0; e < 4; ++e) {
                acc = fmaf(__uint_as_float(wv[e] << 16), __uint_as_float(hv[e] << 16), acc);
                acc = fmaf(__uint_as_float(wv[e] & 0xffff0000u), __uint_as_float(hv[e] & 0xffff0000u), acc);
            }
        }
        const float partner = __shfl_xor(acc, 16);
        float o = acc;
        if (mode == 0) o = silu_f(acc) * 0.08838834764831845f;
        else if (mode == 1) { const float lb = LB[col - 1024]; const float f = lb + (1.0f - lb) * sigmoid_f(acc); LOGF[(size_t)t * 1024 + col - 1024] = logf(f); o = 1.0f - f; }
        else if (mode == 3 || mode == 7) o = silu_f(acc);
        else if (mode == 4 || mode == 5) {
            const int hi = ci >> 4, d = (col - 4096) & 127;
            const float cs = RC[(size_t)t * 128 + d], sn = RS[(size_t)t * 128 + d];
            const float x1 = hi ? partner : acc, x2 = hi ? acc : partner;
            o = hi ? (x1 * sn + x2 * cs) : (x1 * cs - x2 * sn);
            if (mode == 5) o *= 0.0625f;
        }
        PROJ[(size_t)t * NPROJ + col] = (bf16)f2bf(o);
    }
    __syncthreads();
}

struct Args { const float* in[17]; float* out; unsigned char* ws; };
__global__ void __launch_bounds__(NWAVES * 64, 2) mega_fwd(Args args) {
    extern __shared__ __attribute__((aligned(16))) unsigned char lds_raw[];
    Frame F;
    F.lds = (LAS unsigned char*)lds_raw;
    F.MISC = (volatile LAS unsigned*)(F.lds + MISC_OFF);
    F.tid = threadIdx.x; F.lane = F.tid & 63; F.wave = __builtin_amdgcn_readfirstlane(F.tid >> 6); F.G = gridDim.x;
    F.x = args.in[0]; F.meta = args.in[1]; F.ln_in_g = args.in[2]; F.ln_in_b = args.in[3]; F.hlb = args.in[4]; F.w_in = args.in[5]; F.hg_ng = args.in[6]; F.ret_ng = args.in[7];
    F.ret_nb = args.in[8]; F.w_out = args.in[9]; F.ln1_g = args.in[10]; F.ln1_b = args.in[11]; F.w_gate = args.in[12]; F.w_up = args.in[13]; F.w_down = args.in[14];
    F.ln2_g = args.in[15]; F.ln2_b = args.in[16]; F.out = args.out; F.ws = args.ws;
    unsigned char* ws = args.ws;
    float* LB = (float*)(ws + WS_LB); float* ST0 = (float*)(ws + WS_ST0); float* ST1 = (float*)(ws + WS_ST1); bf16* HM = (bf16*)(ws + WS_HM);
    bf16* WINT = (bf16*)(ws + WS_WIN); bf16* WOUTT = (bf16*)(ws + WS_WOUT); bf16* WDOWNT = (bf16*)(ws + WS_WDOWN); bf16* WGUT = (bf16*)(ws + WS_WGU);
    bf16* H0B = (bf16*)(ws + WS_H0B); bf16* MIX = (bf16*)(ws + WS_MIX); bf16* H1B = (bf16*)(ws + WS_H1B); bf16* PROJ = (bf16*)(ws + WS_PROJ);
    float* Z = (float*)(ws + WS_Z); bf16* ACT = (bf16*)(ws + WS_ACT); float* LOGF = (float*)(ws + WS_LOGF);
    float* RC = (float*)((unsigned char*)args.out + DO_RC); float* RS = (float*)((unsigned char*)args.out + DO_RS);
    float* HGO = args.out; float* RETO = args.out + (size_t)SEQ * 1024;
    for (int u = F.tid; u < (LDS_BYTES - LDSCTL_OFF) / 4; u += NWAVES * 64) ((LAS unsigned*)(F.lds + LDSCTL_OFF))[u] = 0u;
    __syncthreads();
    XcdBarrier bar = xcd_barrier_post((unsigned*)(ws + WS_CTL) + CW_BAR, F.MISC + 8);
    const int gw = blockIdx.x * NWAVES + F.wave, NGW = F.G * NWAVES;

    {
        LAS float* scr = (LAS float*)(F.lds + RING_OFF + F.wave * 16384);
        constexpr int I_IN = (DM / 64) * (NPROJ / 32);
        for (int it = gw; it < I_IN; it += NGW) transpose_item<0>(F.w_in, DM, NPROJ, WINT, scr, it, F.lane);
        for (int m = gw; m < SEQ; m += NGW) ln_row(F.x + (size_t)m * DM, false, F.ln_in_g, F.ln_in_b, H0B + (size_t)m * DM, nullptr, ST0 + 2 * m, F.lane);
        if (gw < 16) ln_row(F.meta + (size_t)gw * DM, false, F.ln_in_g, F.ln_in_b, HM + (size_t)gw * DM, nullptr, nullptr, F.lane);
        for (int t = gw; t < LT; t += NGW) {
#pragma unroll
            for (int hh = 0; hh < 2; ++hh) {
                const int d = F.lane + 64 * hh;
                const float invf = (float)pow(10000.0, -(double)d / 128.0);
                const float ang = (float)(t - PADF) * invf;
                RC[(size_t)t * 128 + d] = (float)cos((double)ang); RS[(size_t)t * 128 + d] = (float)sin((double)ang);
            }
        }
        if (gw < 16) { const int jx = gw * 64 + F.lane; LB[jx] = 1.0f / (1.0f + expf(F.hlb[1024 + jx] - F.hlb[jx])); }
        for (int i = blockIdx.x * 512 + F.tid; i < PADF * NPROJ * 2 / 16; i += F.G * 512) *((GAS v4u*)PROJ + i) = (v4u){0u, 0u, 0u, 0u};
        for (int i = blockIdx.x * 512 + F.tid; i < PADF * 1024 * 4 / 16; i += F.G * 512) *((GAS v4u*)LOGF + i) = (v4u){0u, 0u, 0u, 0u};
    }
    xcd_barrier(bar);

    {
        meta_proj(F, WINT, HM, PROJ, LOGF, LB, RC, RS);
        pg8::Gemm g{H0B, WINT, SEQ, NPROJ, DM}; pg8::StaticOrder S; S.init(SEQ, NPROJ, F.G, (int)blockIdx.x);
        pg8::EpiProj E{PROJ, LOGF, LB, RC, RS};
        pg8::gemm_phase<pg8::EpiProj, pg8::StaticOrder, true, true>(F.lds + RING_OFF, g, S, E);
    }
    xcd_barrier(bar);

    {
        const int nscan = F.G >= 128 ? 64 : 0;
        if (nscan == 0 || (int)blockIdx.x < 64) {
            for (int it = blockIdx.x; it < 64; it += (nscan ? 64 : F.G)) {
                if (it < 32) hgrn_scan(F.lds, PROJ, LOGF, HGO, it >> 2, it & 3);
                else ret_scan(F.lds, PROJ, RETO, (it - 32) >> 3, (it - 32) & 7);
            }
        }
        if (nscan == 0 || (int)blockIdx.x >= 64) {
            LAS float* scr = (LAS float*)(F.lds + RING_OFF + F.wave * 16384);
            const int cw = (nscan ? ((int)blockIdx.x - 64) : (int)blockIdx.x) * NWAVES + F.wave, NCW = (nscan ? F.G - 64 : F.G) * NWAVES;
            constexpr int I_O = (DM / 64) * (DM / 32), I_D = (DFF / 64) * (DM / 32), I_G = (DM / 64) * (DFF / 32);
            for (int it = cw; it < I_O + I_D + 2 * I_G; it += NCW) {
                int r = it;
                if (r < I_O) { transpose_item<0>(F.w_out, DM, DM, WOUTT, scr, r, F.lane); continue; } r -= I_O;
                if (r < I_D) { transpose_item<0>(F.w_down, DFF, DM, WDOWNT, scr, r, F.lane); continue; } r -= I_D;
                if (r < I_G) { transpose_item<1>(F.w_gate, DM, DFF, WGUT, scr, r, F.lane); continue; } r -= I_G;
                transpose_item<2>(F.w_up, DM, DFF, WGUT, scr, r, F.lane);
            }
        }
    }
    xcd_barrier(bar);

    for (int r = gw; r < SEQ; r += NGW) {
        const int t = r + PADM, c0 = 16 * F.lane;
        {
            f32x4 o[4]; float s = 0.f;
#pragma unroll
            for (int i = 0; i < 4; ++i) { o[i] = *(const GAS f32x4*)(HGO + (size_t)r * 1024 + c0 + 4 * i); s += (o[i].x * o[i].x + o[i].y * o[i].y) + (o[i].z * o[i].z + o[i].w * o[i].w); }
            s += __shfl_xor(s, 1); s += __shfl_xor(s, 2); s += __shfl_xor(s, 4);
            const float rs = 1.0f / sqrtf(s * (1.f / 128.f) + 1e-6f);
            const v4u g0 = *(const GAS v4u*)(PROJ + (size_t)t * NPROJ + 3072 + c0), g1 = *(const GAS v4u*)(PROJ + (size_t)t * NPROJ + 3072 + c0 + 8);
            unsigned wout[8];
#pragma unroll
            for (int i = 0; i < 4; ++i) {
                const f32x4 ng = *(const GAS f32x4*)(F.hg_ng + c0 + 4 * i);
                const unsigned ga = (i < 2) ? g0[2 * i] : g1[2 * (i - 2)], gb = (i < 2) ? g0[2 * i + 1] : g1[2 * (i - 2) + 1];
                const float y0 = o[i].x * rs * ng.x * __uint_as_float(ga << 16), y1 = o[i].y * rs * ng.y * __uint_as_float(ga & 0xffff0000u);
                const float y2 = o[i].z * rs * ng.z * __uint_as_float(gb << 16), y3 = o[i].w * rs * ng.w * __uint_as_float(gb & 0xffff0000u);
                wout[2 * i] = pk2(y0, y1); wout[2 * i + 1] = pk2(y2, y3);
            }
            *(GAS v4u*)(MIX + (size_t)r * DM + c0) = (v4u){wout[0], wout[1], wout[2], wout[3]};
            *(GAS v4u*)(MIX + (size_t)r * DM + c0 + 8) = (v4u){wout[4], wout[5], wout[6], wout[7]};
        }
        {
            f32x4 o[4]; float s = 0.f;
#pragma unroll
            for (int i = 0; i < 4; ++i) { o[i] = *(const GAS f32x4*)(RETO + (size_t)r * 1024 + c0 + 4 * i); s += (o[i].x + o[i].y) + (o[i].z + o[i].w); }
            s += __shfl_xor(s, 1); s += __shfl_xor(s, 2); s += __shfl_xor(s, 4); s += __shfl_xor(s, 8);
            const float mu = s * (1.f / 256.f); float q = 0.f;
#pragma unroll
            for (int i = 0; i < 4; ++i) { o[i] = o[i] - mu; q += (o[i].x * o[i].x + o[i].y * o[i].y) + (o[i].z * o[i].z + o[i].w * o[i].w); }
            q += __shfl_xor(q, 1); q += __shfl_xor(q, 2); q += __shfl_xor(q, 4); q += __shfl_xor(q, 8);
            const float rs = 1.0f / sqrtf(q * (1.f / 256.f) + 1e-6f);
            const v4u g0 = *(const GAS v4u*)(PROJ + (size_t)t * NPROJ + 7168 + c0), g1 = *(const GAS v4u*)(PROJ + (size_t)t * NPROJ + 7168 + c0 + 8);
            unsigned wout[8];
#pragma unroll
            for (int i = 0; i < 4; ++i) {
                const f32x4 ng = *(const GAS f32x4*)(F.ret_ng + c0 + 4 * i), nb = *(const GAS f32x4*)(F.ret_nb + c0 + 4 * i);
                const unsigned ga = (i < 2) ? g0[2 * i] : g1[2 * (i - 2)], gb = (i < 2) ? g0[2 * i + 1] : g1[2 * (i - 2) + 1];
                const float y0 = (o[i].x * rs * ng.x + nb.x) * __uint_as_float(ga << 16), y1 = (o[i].y * rs * ng.y + nb.y) * __uint_as_float(ga & 0xffff0000u);
                const float y2 = (o[i].z * rs * ng.z + nb.z) * __uint_as_float(gb << 16), y3 = (o[i].w * rs * ng.w + nb.w) * __uint_as_float(gb & 0xffff0000u);
                wout[2 * i] = pk2(y0, y1); wout[2 * i + 1] = pk2(y2, y3);
            }
            *(GAS v4u*)(MIX + (size_t)r * DM + 1024 + c0) = (v4u){wout[0], wout[1], wout[2], wout[3]};
            *(GAS v4u*)(MIX + (size_t)r * DM + 1024 + c0 + 8) = (v4u){wout[4], wout[5], wout[6], wout[7]};
        }
    }
    xcd_barrier(bar);

    {
        pg8::Gemm g{MIX, WOUTT, SEQ, DM, DM}; pg8::StaticOrder S; S.init(SEQ, DM, F.G, (int)blockIdx.x);
        pg8::EpiResid E{F.x, ST0, F.ln_in_g, F.ln_in_b, Z};
        pg8::gemm_phase<pg8::EpiResid, pg8::StaticOrder, true, true>(F.lds + RING_OFF, g, S, E);
    }
    xcd_barrier(bar);
    for (int m = gw; m < SEQ; m += NGW) ln_row(Z + (size_t)m * DM, false, F.ln1_g, F.ln1_b, H1B + (size_t)m * DM, nullptr, ST1 + 2 * m, F.lane);
    xcd_barrier(bar);
    {
        pg8::Gemm g{H1B, WGUT, SEQ, 2 * DFF, DM}; pg8::StaticOrder S; S.init(SEQ, 2 * DFF, F.G, (int)blockIdx.x);
        pg8::EpiGU E{ACT};
        pg8::gemm_phase<pg8::EpiGU, pg8::StaticOrder, true, true>(F.lds + RING_OFF, g, S, E);
    }
    xcd_barrier(bar);
    {
        pg8::Gemm g{ACT, WDOWNT, SEQ, DM, DFF}; pg8::StaticOrder S; S.init(SEQ, DM, F.G, (int)blockIdx.x);
        pg8::EpiResid E{Z, ST1, F.ln1_g, F.ln1_b, F.out};
        pg8::gemm_phase<pg8::EpiResid, pg8::StaticOrder, true, true>(F.lds + RING_OFF, g, S, E);
    }
    xcd_barrier(bar);
    for (int m = gw; m < SEQ; m += NGW) ln_row(F.out + (size_t)m * DM, false, F.ln2_g, F.ln2_b, nullptr, F.out + (size_t)m * DM, nullptr, F.lane);
}

extern "C" void kernel_launch(void* const* d_in, const int* in_sizes, int n_in, void* d_out, int out_size, void* d_ws, size_t ws_size, hipStream_t stream) {
    static int grid = 0;
    if (grid == 0) {
        if (n_in != 17 || out_size != SEQ * DM || ws_size < WS_END) { fprintf(stderr, "kernel_launch: unexpected shapes (n_in %d out %d ws %zu)\n", n_in, out_size, ws_size); grid = -1; return; }
        int dev = 0, cus = 0, per_cu = 0;
        if (hipGetDevice(&dev) != hipSuccess || hipDeviceGetAttribute(&cus, hipDeviceAttributeMultiprocessorCount, dev) != hipSuccess) { grid = -1; return; }
        if (hipFuncSetAttribute((const void*)mega_fwd, hipFuncAttributeMaxDynamicSharedMemorySize, LDS_BYTES) != hipSuccess) { fprintf(stderr, "kernel_launch: hipFuncSetAttribute failed\n"); grid = -1; return; }
        if (hipOccupancyMaxActiveBlocksPerMultiprocessor(&per_cu, (const void*)mega_fwd, NWAVES * 64, LDS_BYTES) != hipSuccess || per_cu < 1) { fprintf(stderr, "kernel_launch: occupancy query says %d\n", per_cu); (void)hipGetLastError(); per_cu = 1; }
        grid = cus * 1;
    }
    if (grid < 0) return;
    (void)hipMemsetAsync((char*)d_ws + WS_CTL, 0, CTL_ZERO_BYTES, stream);
    Args a{};
    for (int i = 0; i < 17; ++i) a.in[i] = (const float*)d_in[i];
    a.out = (float*)d_out; a.ws = (unsigned char*)d_ws;
    void* kargs[] = {&a};
    hipError_t e = hipLaunchCooperativeKernel((const void*)mega_fwd, dim3(grid), dim3(NWAVES * 64), kargs, LDS_BYTES, stream);
    if (e != hipSuccess) fprintf(stderr, "kernel_launch: cooperative launch failed: %s (grid %d)\n", hipGetErrorString(e), grid);
}
```

```cpp
#include <hip/hip_runtime.h>
#include <cstdio>
#include <cstdint>
#include <math.h>

namespace pg8 {
#define PG8_LAS __attribute__((address_space(3)))
typedef unsigned short bf16_t;
typedef short bf16x8 __attribute__((ext_vector_type(8)));
typedef float f32x4 __attribute__((ext_vector_type(4)));
typedef unsigned u32x4 __attribute__((ext_vector_type(4)));
constexpr int BM = 256, BK = 64, HALF = 128, HTB = HALF * BK * 2  , STAGE_BYTES = 8 * HTB, NXCD = 8, WGM = 8;

__host__ __device__ __forceinline__ int lds_byte(int r, int c) { const int st = (r >> 4) * 2 + (c >> 5), rr = r & 15, cc = c & 31, ob = rr * 64 + cc * 2; return st * 1024 + (ob ^ (((ob >> 9) & 1) << 5)); }
__host__ __device__ __forceinline__ void stage_rc(int b, int& R, int& C) { const int st = b / 1024, sb = b % 1024, swz = sb ^ (((sb >> 9) & 1) << 5); R = (st >> 1) * 16 + swz / 64; C = (st & 1) * 32 + (swz % 64) / 2; }
__host__ __device__ __forceinline__ int perm32(int rho) { const int n = rho >> 4, i = rho & 15; return 8 * (i >> 2) + 4 * n + (i & 3); }

struct Unit { int pm, pn; };
struct Gemm { const bf16_t* A; const bf16_t* Bt; int M, N, K; };

struct StaticOrder {
    int nM, nN, nwg, G, c;
    __host__ __device__ void init(int M, int N, int G_, int c_) { nM = M / BM; nN = N / BM; nwg = nM * nN; G = G_; c = c_; }
    __host__ __device__ bool next(int i, Unit& u) const {
        const long L = (long)i * G + c; if (L >= nwg) return false;
        int wgid = (int)L; { const int q = nwg / NXCD, r = nwg % NXCD, xcd = wgid % NXCD, off = wgid / NXCD; wgid = (xcd < r ? xcd * (q + 1) : r * (q + 1) + (xcd - r) * q) + off; }
        const int nig = WGM * nN, gid = wgid / nig, fm = gid * WGM, gsz = (nM - fm) < WGM ? (nM - fm) : WGM;
        u.pm = fm + ((wgid % nig) % gsz); u.pn = (wgid % nig) / gsz; return true;
    }
    __device__ __forceinline__ void a_ready(const Unit&) const {}
    __device__ __forceinline__ void done(const Unit&) const {}
};

__device__ __forceinline__ unsigned cvt_pk_bf16(float lo, float hi) { unsigned r; asm volatile("v_cvt_pk_bf16_f32 %0, %1, %2" : "=v"(r) : "v"(lo), "v"(hi)); return r; }
__device__ __forceinline__ float fexp(float x) { return __builtin_amdgcn_exp2f(x * 1.4426950408889634f); }
__device__ __forceinline__ float silu_f(float x) { return x * __builtin_amdgcn_rcpf(1.0f + fexp(-x)); }
__device__ __forceinline__ float sigmoid_f(float x) { return __builtin_amdgcn_rcpf(1.0f + fexp(-x)); }

constexpr int NPROJ = 8192, DM = 2048, DFF = 5632, PADM = 64;
constexpr float ALPHA = 1.18920711500272f;


struct EpiProj {
    static constexpr bool PERM = true, AFTER_DRAIN = false;
    bf16_t* PROJ; float* LOGF; const float* LB; const float* RC; const float* RS;
    __device__ __forceinline__ void operator()(const f32x4 (&acc)[2][2][4][2], const Unit& u, int wr, int wc, int fr, int fq) const {
        const int cgp = u.pn >> 2, row0 = u.pm * BM + wr * 64 + fr, cl = wc * 32 + 8 * fq;
        if (cgp == 4 || cgp == 5) {
            const float sc = (cgp == 5) ? 0.0625f : 1.0f;
#pragma unroll
            for (int ai = 0; ai < 2; ++ai)
#pragma unroll
                for (int m = 0; m < 4; ++m) {
                    const int t = row0 + ai * HALF + m * 16 + PADM;
                    u32x4 w1, w2;
#pragma unroll
                    for (int n = 0; n < 2; ++n) {
                        const f32x4 cs = *(const f32x4*)(RC + (size_t)t * 128 + cl + 4 * n), sn = *(const f32x4*)(RS + (size_t)t * 128 + cl + 4 * n);
                        const f32x4 x1 = acc[ai][0][m][n], x2 = acc[ai][1][m][n];
                        const f32x4 o1 = (x1 * cs - x2 * sn) * sc, o2 = (x1 * sn + x2 * cs) * sc;
                        if (n == 0) { w1.x = cvt_pk_bf16(o1[0], o1[1]); w1.y = cvt_pk_bf16(o1[2], o1[3]); w2.x = cvt_pk_bf16(o2[0], o2[1]); w2.y = cvt_pk_bf16(o2[2], o2[3]); }
                        else        { w1.z = cvt_pk_bf16(o1[0], o1[1]); w1.w = cvt_pk_bf16(o1[2], o1[3]); w2.z = cvt_pk_bf16(o2[0], o2[1]); w2.w = cvt_pk_bf16(o2[2], o2[3]); }
                    }
                    bf16_t* rowp = PROJ + (size_t)t * NPROJ + u.pn * BM + cl;
                    *(u32x4*)rowp = w1; *(u32x4*)(rowp + HALF) = w2;
                }
        } else {
#pragma unroll
            for (int bj = 0; bj < 2; ++bj) {
                const int c0 = u.pn * BM + bj * HALF + cl;
                f32x4 lb0 = (f32x4){0.f, 0.f, 0.f, 0.f}, lb1 = lb0;
                if (cgp == 1) { lb0 = *(const f32x4*)(LB + (c0 - 1024)); lb1 = *(const f32x4*)(LB + (c0 - 1024) + 4); }
#pragma unroll
                for (int ai = 0; ai < 2; ++ai)
#pragma unroll
                    for (int m = 0; m < 4; ++m) {
                        const int t = row0 + ai * HALF + m * 16 + PADM;
                        f32x4 v0 = acc[ai][bj][m][0], v1 = acc[ai][bj][m][1];
                        if (cgp == 0) {
#pragma unroll
                            for (int e = 0; e < 4; ++e) { v0[e] = silu_f(v0[e]) * 0.08838834764831845f; v1[e] = silu_f(v1[e]) * 0.08838834764831845f; }
                        } else if (cgp == 1) {
                            f32x4 l0, l1;
#pragma unroll
                            for (int e = 0; e < 4; ++e) {
                                const float f0 = lb0[e] + (1.0f - lb0[e]) * sigmoid_f(v0[e]), f1 = lb1[e] + (1.0f - lb1[e]) * sigmoid_f(v1[e]);
                                l0[e] = logf(f0); l1[e] = logf(f1); v0[e] = 1.0f - f0; v1[e] = 1.0f - f1;
                            }
                            float* lp = LOGF + (size_t)t * 1024 + (c0 - 1024);
                            *(f32x4*)lp = l0; *(f32x4*)(lp + 4) = l1;
                        } else if (cgp == 3 || cgp == 7) {
#pragma unroll
                            for (int e = 0; e < 4; ++e) { v0[e] = silu_f(v0[e]); v1[e] = silu_f(v1[e]); }
                        }
                        u32x4 w; w.x = cvt_pk_bf16(v0[0], v0[1]); w.y = cvt_pk_bf16(v0[2], v0[3]); w.z = cvt_pk_bf16(v1[0], v1[1]); w.w = cvt_pk_bf16(v1[2], v1[3]);
                        *(u32x4*)(PROJ + (size_t)t * NPROJ + c0) = w;
                    }
            }
        }
    }
};

struct EpiResid {
    static constexpr bool PERM = false, AFTER_DRAIN = false;
    const float* src; const float* st; const float* g; const float* b; float* out;
    __device__ __forceinline__ void operator()(const f32x4 (&acc)[2][2][4][2], const Unit& u, int wr, int wc, int fr, int fq) const {
        const int row0 = u.pm * BM + wr * 64 + fr, col0 = u.pn * BM + wc * 32 + 4 * fq;
        f32x4 gv[2][2], bv[2][2];
#pragma unroll
        for (int bj = 0; bj < 2; ++bj)
#pragma unroll
            for (int n = 0; n < 2; ++n) { gv[bj][n] = *(const f32x4*)(g + col0 + bj * HALF + n * 16); bv[bj][n] = *(const f32x4*)(b + col0 + bj * HALF + n * 16); }
#pragma unroll
        for (int ai = 0; ai < 2; ++ai)
#pragma unroll
            for (int m = 0; m < 4; ++m) {
                const int r = row0 + ai * HALF + m * 16; const float mu = st[2 * r], rstd = st[2 * r + 1];
                const size_t off = (size_t)r * DM + col0;
#pragma unroll
                for (int bj = 0; bj < 2; ++bj)
#pragma unroll
                    for (int n = 0; n < 2; ++n) {
                        const f32x4 xv = *(const f32x4*)(src + off + bj * HALF + n * 16);
                        const f32x4 hv = (xv - mu) * rstd * gv[bj][n] + bv[bj][n];
                        *(f32x4*)(out + off + bj * HALF + n * 16) = hv * ALPHA + acc[ai][bj][m][n];
                    }
            }
    }
};

struct EpiGU {
    static constexpr bool PERM = true, AFTER_DRAIN = false;
    bf16_t* ACT;
    __device__ __forceinline__ void operator()(const f32x4 (&acc)[2][2][4][2], const Unit& u, int wr, int wc, int fr, int fq) const {
        const int row0 = u.pm * BM + wr * 64 + fr, c0 = u.pn * HALF + wc * 32 + 8 * fq;
#pragma unroll
        for (int ai = 0; ai < 2; ++ai)
#pragma unroll
            for (int m = 0; m < 4; ++m) {
                const int r = row0 + ai * HALF + m * 16;
                f32x4 v0, v1;
#pragma unroll
                for (int e = 0; e < 4; ++e) { v0[e] = silu_f(acc[ai][0][m][0][e]) * acc[ai][1][m][0][e]; v1[e] = silu_f(acc[ai][0][m][1][e]) * acc[ai][1][m][1][e]; }
                u32x4 w; w.x = cvt_pk_bf16(v0[0], v0[1]); w.y = cvt_pk_bf16(v0[2], v0[3]); w.z = cvt_pk_bf16(v1[0], v1[1]); w.w = cvt_pk_bf16(v1[2], v1[3]);
                *(u32x4*)(ACT + (size_t)r * DFF + c0) = w;
            }
    }
};

template <class Epi, class Sched, bool ALIGN_EPI = false, bool SP2 = false>
__device__ __forceinline__ void gemm_phase(PG8_LAS unsigned char* lds, const Gemm g, const Sched& S, const Epi& E) {
    int tid_ = threadIdx.x; asm volatile("" : "+v"(tid_));
    const int tid = tid_, wid = __builtin_amdgcn_readfirstlane(tid >> 6), lane = tid & 63, wr = wid >> 2, wc = wid & 3, fr = lane & 15, fq = lane >> 4;
    const int K = g.K, nt = K / BK;
    unsigned voffA[2], voffB[2];
#pragma unroll
    for (int i = 0; i < 2; ++i) { int R, C; stage_rc(tid * 16 + i * 8192, R, C); const int Rb = Epi::PERM ? ((R & ~31) + perm32(R & 31)) : R;
        voffA[i] = (unsigned)(R * K + C) * 2u; voffB[i] = (unsigned)(Rb * K + C) * 2u; }
    const size_t kstep = (size_t)(BK * 2);
    const size_t hstep = (size_t)HALF * K * 2;
    const size_t tstep = 2 * hstep;
    const unsigned ldsw = (unsigned)wid * 1024u;
    const int aoff = lds_byte(wr * 64 + fr, fq * 8), boff = lds_byte(wc * 32 + fr, fq * 8);
#define PG8_SA(b, h) (((b) * 2 + (h)) * HTB)
#define PG8_SB(b, h) ((4 + (b) * 2 + (h)) * HTB)
#define PG8_STAGE(bufoff, gbase, voff) do { _Pragma("unroll") for (int _i = 0; _i < 2; ++_i) \
        __builtin_amdgcn_global_load_lds((const unsigned*)((const char*)(gbase) + (voff)[_i]), (PG8_LAS unsigned*)(lds + (bufoff) + ldsw + _i * 8192), 16, 0, 0); } while (0)
#define PG8_LDA(dst, b, h) do { _Pragma("unroll") for (int m = 0; m < 4; ++m) _Pragma("unroll") for (int k = 0; k < 2; ++k) dst[m][k] = *(const PG8_LAS bf16x8*)(lds + PG8_SA(b, h) + aoff + m * 2048 + k * 1024); } while (0)
#define PG8_LDB(dst, b, h) do { _Pragma("unroll") for (int n = 0; n < 2; ++n) _Pragma("unroll") for (int k = 0; k < 2; ++k) dst[n][k] = *(const PG8_LAS bf16x8*)(lds + PG8_SB(b, h) + boff + n * 2048 + k * 1024); } while (0)
#define PG8_MMA(ai, bj, At, Bt) do { __builtin_amdgcn_s_setprio(1); _Pragma("unroll") for (int m = 0; m < 4; ++m) _Pragma("unroll") for (int n = 0; n < 2; ++n) _Pragma("unroll") for (int k = 0; k < 2; ++k) \
        acc[ai][bj][m][n] = __builtin_amdgcn_mfma_f32_16x16x32_bf16(Bt[n][k], At[m][k], acc[ai][bj][m][n], 0, 0, 0); __builtin_amdgcn_s_setprio(0); } while (0)
#define PG8_WAIT_V(n) asm volatile("s_waitcnt vmcnt(" #n ")" ::: "memory")
#define PG8_WAIT_L(n) asm volatile("s_waitcnt lgkmcnt(" #n ")" ::: "memory")
#define PG8_BAR __builtin_amdgcn_s_barrier()
#define PG8_SCHED __builtin_amdgcn_sched_barrier(0)
    Unit cur, nxt; int ui = 0;
    if (!S.next(0, cur)) return;
    f32x4 acc[2][2][4][2];
#pragma unroll
    for (int a = 0; a < 2; ++a)
#pragma unroll
        for (int b = 0; b < 2; ++b)
#pragma unroll
            for (int m = 0; m < 4; ++m)
#pragma unroll
                for (int n = 0; n < 2; ++n) acc[a][b][m][n] = (f32x4){0.f, 0.f, 0.f, 0.f};
    bf16x8 At[4][2], B0[2][2], B1[2][2];
    const char* cA = (const char*)g.A + (size_t)cur.pm * tstep; const char* cB = (const char*)g.Bt + (size_t)cur.pn * tstep;
    S.a_ready(cur);
    if constexpr (SP2) {
        PG8_STAGE(PG8_SB(0, 0), cB, voffB); PG8_STAGE(PG8_SB(0, 1), cB + hstep, voffB); PG8_STAGE(PG8_SA(0, 0), cA, voffA); PG8_STAGE(PG8_SA(0, 1), cA + hstep, voffA);
        if (wr == 1) PG8_BAR;
        PG8_WAIT_V(2); PG8_BAR;
        PG8_STAGE(PG8_SB(1, 0), cB + kstep, voffB); PG8_STAGE(PG8_SA(1, 0), cA + kstep, voffA); PG8_STAGE(PG8_SB(1, 1), cB + hstep + kstep, voffB);
        PG8_WAIT_V(6); PG8_BAR;
    } else {
        PG8_STAGE(PG8_SB(0, 0), cB, voffB); PG8_STAGE(PG8_SA(0, 0), cA, voffA); PG8_STAGE(PG8_SB(0, 1), cB + hstep, voffB); PG8_STAGE(PG8_SA(0, 1), cA + hstep, voffA);
        if (wr == 1) PG8_BAR;
        PG8_WAIT_V(4); PG8_BAR;
        PG8_STAGE(PG8_SB(1, 0), cB + kstep, voffB); PG8_STAGE(PG8_SA(1, 0), cA + kstep, voffA); PG8_STAGE(PG8_SB(1, 1), cB + hstep + kstep, voffB);
        PG8_WAIT_V(6); PG8_BAR;
    }
    for (;;) {
        const bool has_next = S.next(ui + 1, nxt);
        const char* nA = has_next ? (const char*)g.A + (size_t)nxt.pm * tstep : cA; const char* nB = has_next ? (const char*)g.Bt + (size_t)nxt.pn * tstep : cB;
        for (int t = 0; t < nt; t += 2) {
            const bool last = (t == nt - 2);
            const char* a1 = cA + (size_t)(t + 1) * kstep;
            const char* a2 = last ? nA : cA + (size_t)(t + 2) * kstep; const char* b2 = last ? nB : cB + (size_t)(t + 2) * kstep;
            const char* a3 = a2 + kstep; const char* b3 = b2 + kstep;
            if (last && has_next) S.a_ready(nxt);
            if constexpr (SP2) {
            PG8_LDB(B0, 0, 0); PG8_LDB(B1, 0, 1); PG8_SCHED; PG8_LDA(At, 0, 0); PG8_STAGE(PG8_SA(1, 1), a1 + hstep, voffA);
            PG8_WAIT_V(8); PG8_WAIT_L(0); PG8_BAR; PG8_MMA(0, 0, At, B0); PG8_MMA(0, 1, At, B1); PG8_BAR; PG8_SCHED;
            PG8_LDA(At, 0, 1); PG8_STAGE(PG8_SB(0, 0), b2, voffB); PG8_STAGE(PG8_SB(0, 1), b2 + hstep, voffB); PG8_STAGE(PG8_SA(0, 0), a2, voffA);
            PG8_WAIT_V(8); PG8_WAIT_L(0); PG8_BAR; PG8_MMA(1, 0, At, B0); PG8_MMA(1, 1, At, B1); PG8_BAR; PG8_SCHED;
            PG8_LDB(B0, 1, 0); PG8_LDB(B1, 1, 1); PG8_SCHED; PG8_LDA(At, 1, 0); PG8_STAGE(PG8_SA(0, 1), a2 + hstep, voffA);
            PG8_WAIT_V(8); PG8_WAIT_L(0); PG8_BAR; PG8_MMA(0, 0, At, B0); PG8_MMA(0, 1, At, B1); PG8_BAR; PG8_SCHED;
            PG8_LDA(At, 1, 1); PG8_STAGE(PG8_SB(1, 0), b3, voffB); PG8_STAGE(PG8_SB(1, 1), b3 + hstep, voffB); PG8_STAGE(PG8_SA(1, 0), a3, voffA);
            PG8_WAIT_V(8); PG8_WAIT_L(0); PG8_BAR; PG8_MMA(1, 0, At, B0); PG8_MMA(1, 1, At, B1); PG8_BAR; PG8_SCHED;
            } else {
            PG8_LDB(B0, 0, 0); PG8_SCHED; PG8_LDA(At, 0, 0); PG8_STAGE(PG8_SA(1, 1), a1 + hstep, voffA);
            PG8_WAIT_L(8); PG8_BAR; PG8_WAIT_L(0); PG8_MMA(0, 0, At, B0); PG8_BAR; PG8_SCHED;
            PG8_LDB(B1, 0, 1); PG8_STAGE(PG8_SB(0, 0), b2, voffB);
            PG8_BAR; PG8_WAIT_L(0); PG8_MMA(0, 1, At, B1); PG8_BAR;
            PG8_LDA(At, 0, 1); PG8_STAGE(PG8_SA(0, 0), a2, voffA);
            PG8_BAR; PG8_WAIT_L(0); PG8_MMA(1, 0, At, B0); PG8_BAR; PG8_SCHED;
            PG8_STAGE(PG8_SB(0, 1), b2 + hstep, voffB);
            PG8_WAIT_V(6); PG8_BAR; PG8_MMA(1, 1, At, B1); PG8_BAR;
            PG8_LDB(B0, 1, 0); PG8_SCHED; PG8_LDA(At, 1, 0); PG8_STAGE(PG8_SA(0, 1), a2 + hstep, voffA);
            PG8_WAIT_L(8); PG8_BAR; PG8_WAIT_L(0); PG8_MMA(0, 0, At, B0); PG8_BAR; PG8_SCHED;
            PG8_LDB(B1, 1, 1); PG8_STAGE(PG8_SB(1, 0), b3, voffB);
            PG8_BAR; PG8_WAIT_L(0); PG8_MMA(0, 1, At, B1); PG8_BAR;
            PG8_LDA(At, 1, 1); PG8_STAGE(PG8_SA(1, 0), a3, voffA);
            PG8_BAR; PG8_WAIT_L(0); PG8_MMA(1, 0, At, B0); PG8_BAR; PG8_SCHED;
            PG8_STAGE(PG8_SB(1, 1), b3 + hstep, voffB);
            PG8_WAIT_V(6); PG8_BAR; PG8_MMA(1, 1, At, B1); PG8_BAR;
            }
        }
        if constexpr (ALIGN_EPI) { if (wr == 0) PG8_BAR; }
        if constexpr (!Epi::AFTER_DRAIN) { E(acc, cur, wr, wc, fr, fq); S.done(cur); }
        if (!has_next) break;
#pragma unroll
        for (int a = 0; a < 2; ++a)
#pragma unroll
            for (int b = 0; b < 2; ++b)
#pragma unroll
                for (int m = 0; m < 4; ++m)
#pragma unroll
                    for (int n = 0; n < 2; ++n) acc[a][b][m][n] = (f32x4){0.f, 0.f, 0.f, 0.f};
        cur = nxt; cA = nA; cB = nB; ++ui;
        if constexpr (ALIGN_EPI) { if (wr == 1) PG8_BAR; }
    }
    PG8_WAIT_V(0);
    if constexpr (!ALIGN_EPI) { if (wr == 0) PG8_BAR; }
    PG8_BAR;
    if constexpr (Epi::AFTER_DRAIN) { E.fused(acc, cur, wr, wc, fr, fq, lds, wid, lane); S.done(cur); }
#undef PG8_SA
#undef PG8_SB
#undef PG8_STAGE
#undef PG8_LDA
#undef PG8_LDB
#undef PG8_MMA
#undef PG8_WAIT_V
#undef PG8_WAIT_L
#undef PG8_BAR
#undef PG8_SCHED
}
}

constexpr int NWAVES = 8;
constexpr int DM = 2048, SEQ = 8192, LT = 8256, NPROJ = 8192, DFF = 5632, PADM = 64  , PADF = 48, NCHUNK = LT / 64;
constexpr size_t MiB = 1u << 20;
constexpr size_t WS_CTL = 0, CTL_ZERO_BYTES = 64 * 1024;
constexpr size_t WS_LB = 1 * MiB;
constexpr size_t WS_ST0 = 1 * MiB + 64 * 1024;
constexpr size_t WS_ST1 = 1 * MiB + 192 * 1024;
constexpr size_t WS_HM = 1 * MiB + 320 * 1024;
constexpr size_t WS_WIN = 2 * MiB;
constexpr size_t WS_WOUT = 2 * MiB;
constexpr size_t WS_WDOWN = 10 * MiB;
constexpr size_t WS_H0B = 34 * MiB;
constexpr size_t WS_MIX = 34 * MiB;
constexpr size_t WS_H1B = 34 * MiB;
constexpr size_t WS_PROJ = 66 * MiB;
constexpr size_t WS_Z = 66 * MiB;
constexpr size_t WS_ACT = 130 * MiB;
constexpr size_t WS_LOGF = 195 * MiB;
constexpr size_t WS_WGU = 228 * MiB;
constexpr size_t WS_END = 272 * MiB;
static_assert(WS_PROJ + (size_t)LT * NPROJ * 2 <= WS_LOGF && WS_LOGF + (size_t)LT * 1024 * 4 <= WS_WGU && WS_WGU + (size_t)2 * DFF * DM * 2 <= WS_END, "ws map");
static_assert(WS_ACT + (size_t)SEQ * DFF * 2 <= WS_WGU && WS_Z + (size_t)SEQ * DM * 4 <= WS_ACT && WS_WDOWN + (size_t)DM * DFF * 2 <= WS_H0B, "ws map 2");
constexpr size_t DO_RC = 0, DO_RS = (size_t)LT * 128 * 4;
constexpr int CW_BAR = 1024;
constexpr int RING_OFF = 0, RING_BYTES = 131072, LDSCTL_OFF = RING_BYTES, MISC_OFF = LDSCTL_OFF + 320, LDS_BYTES = 147456;

#define GAS __attribute__((address_space(1)))
#define LAS __attribute__((address_space(3)))
typedef unsigned short bf16;
typedef unsigned v4u __attribute__((ext_vector_type(4)));
typedef unsigned v2u __attribute__((ext_vector_type(2)));
typedef float f32x4 __attribute__((ext_vector_type(4)));
typedef short bf16x8 __attribute__((ext_vector_type(8)));
typedef short bf16x4 __attribute__((ext_vector_type(4)));
typedef GAS unsigned gu32;
#define RLX_AGENT __ATOMIC_RELAXED, __HIP_MEMORY_SCOPE_AGENT
#define LDS_WAIT() asm volatile("s_waitcnt lgkmcnt(0)" ::: "memory")
__device__ __forceinline__ float bf2f(bf16 v) { return __uint_as_float((unsigned)v << 16); }
__device__ __forceinline__ unsigned f2bf(float f) { unsigned u = __builtin_bit_cast(unsigned, f); return (u + 0x7fffu + ((u >> 16) & 1u)) >> 16; }
__device__ __forceinline__ unsigned pk2(float lo, float hi) { return f2bf(lo) | (f2bf(hi) << 16); }
using pg8::fexp; using pg8::silu_f; using pg8::sigmoid_f;

#define XB_TMO      128
#define XB_XCNT(j)  (256  + 64 * (j))
#define XB_XSUB(j)  (1280 + 64 * (j))
#define XB_XGEN(j)  (2304 + 64 * (j))
#define XB_TOP      3328
#define XB_TOPGEN   3392
#define XCD_BAR_WORDS 3456
#define XB_SPIN_CAP (1u << 18)

__device__ __forceinline__ unsigned xb_ld(unsigned* p)              { return __hip_atomic_load(p, __ATOMIC_RELAXED, __HIP_MEMORY_SCOPE_AGENT); }
__device__ __forceinline__ unsigned xb_add(unsigned* p, unsigned v) { return __hip_atomic_fetch_add(p, v, __ATOMIC_RELAXED, __HIP_MEMORY_SCOPE_AGENT); }
__device__ __forceinline__ unsigned xb_xcc_id() { return (unsigned)__builtin_amdgcn_s_getreg((3 << 11) | 20) & 0xFu; }
#define XB_SPIN(cond, bar) do { unsigned _sp = 0; while (cond) { __builtin_amdgcn_s_sleep(1); \
    if ((++_sp & 255u) == 0u) { if (xb_ld(&(bar)[XB_TMO])) break; if (_sp > XB_SPIN_CAP) { atomicAdd(&(bar)[XB_TMO], 1u); break; } } } } while (0)

struct XcdBarrier {
    unsigned* bar; unsigned x;
    volatile LAS unsigned* st;
};

__device__ __forceinline__ XcdBarrier xcd_barrier_post(unsigned* bar, volatile LAS unsigned* st) {
    XcdBarrier b; b.bar = bar; b.x = xb_xcc_id(); b.st = st;
    if (threadIdx.x == 0) (void)xb_add(&bar[XB_XCNT(b.x)], 1u);
    return b;
}
__device__ __forceinline__ void xcd_barrier_complete(unsigned* bar, unsigned x, unsigned& nloc, unsigned& nx) {
    const unsigned G = gridDim.x * gridDim.y * gridDim.z;
    unsigned sum, cnt, mine, sp = 0u;
    for (;;) {
        sum = 0u; cnt = 0u; mine = 0u;
#pragma unroll
        for (unsigned j = 0; j < 16; ++j) { const unsigned c = xb_ld(&bar[XB_XCNT(j)]); sum += c; cnt += (c > 0u) ? 1u : 0u; mine = (j == x) ? c : mine; }
        if (sum == G) break;
        __builtin_amdgcn_s_sleep(1);
        if ((++sp & 255u) == 0u) { if (xb_ld(&bar[XB_TMO])) break; if (sp > XB_SPIN_CAP) { atomicAdd(&bar[XB_TMO], 1u); break; } }
    }
    nloc = mine > 0u ? mine : 1u; nx = cnt > 0u ? cnt : 1u;
}

__device__ __forceinline__ void xcd_barrier(const XcdBarrier& b) {
    asm volatile("s_waitcnt vmcnt(0)" ::: "memory");
    __syncthreads();
    if (threadIdx.x == 0) {
        unsigned* bar = b.bar;
        __builtin_amdgcn_s_waitcnt(0);
        unsigned nloc = b.st[0], nx = b.st[1];
        if (nloc == 0u) { xcd_barrier_complete(bar, b.x, nloc, nx); b.st[0] = nloc; b.st[1] = nx; }
        const unsigned old = xb_add(&bar[XB_XSUB(b.x)], 1u);
        const unsigned gen = old / nloc;
        if (old + 1u == (gen + 1u) * nloc) {
            __builtin_amdgcn_fence(__ATOMIC_RELEASE, "agent");
            asm volatile("s_waitcnt vmcnt(0)" ::: "memory");
            const unsigned og = xb_add(&bar[XB_TOP], 1u);
            const unsigned tg = og / nx;
            if (og + 1u == (tg + 1u) * nx) xb_add(&bar[XB_TOPGEN], 1u);
            else XB_SPIN(xb_ld(&bar[XB_TOPGEN]) == tg, bar);
            __builtin_amdgcn_fence(__ATOMIC_ACQUIRE, "agent");
            xb_add(&bar[XB_XGEN(b.x)], 1u);
            asm volatile("s_waitcnt vmcnt(0)" ::: "memory");
        } else {
            XB_SPIN(xb_ld(&bar[XB_XGEN(b.x)]) == gen, bar);
            __builtin_amdgcn_fence(__ATOMIC_ACQUIRE, "agent");
            asm volatile("s_waitcnt vmcnt(0)" ::: "memory");
        }
    }
    __syncthreads();
}

struct Frame {
    LAS unsigned char* lds;
    volatile LAS unsigned* MISC;
    int tid, lane, wave, G;
    const float *x, *meta, *ln_in_g, *ln_in_b, *hlb, *w_in, *hg_ng, *ret_ng, *ret_nb, *w_out, *ln1_g, *ln1_b, *w_gate, *w_up, *w_down, *ln2_g, *ln2_b;
    float* out; unsigned char* ws;
};
__device__ __forceinline__ float wave_sum(float v) {
#pragma unroll
    for (int o = 1; o < 64; o <<= 1) v += __shfl_xor(v, o);
    return v;
}
template <int MAP> __device__ __forceinline__ void transpose_item(const float* W, int K, int N, bf16* WT, LAS float* scr, int item, int lane) {
    const int nblk = N / 32, kb = item / nblk, nb = item % nblk, k0 = 64 * kb, n0 = 32 * nb;
    const int rbase = (MAP == 0) ? n0 : (256 * (n0 >> 7) + (n0 & 127) + (MAP == 2 ? 128 : 0));
#pragma unroll 8
    for (int i = 0; i < 32; ++i) { const int kk = 2 * i + (lane >> 5); scr[kk * 33 + (lane & 31)] = W[(size_t)(k0 + kk) * N + n0 + (lane & 31)]; }
    LDS_WAIT(); asm volatile("" ::: "memory");
    const int c = lane & 7;
#pragma unroll
    for (int j = 0; j < 4; ++j) { const int n = (lane >> 3) + 8 * j; const LAS float* s = scr + (8 * c) * 33 + n;
        v4u o; o.x = pk2(s[0 * 33], s[1 * 33]); o.y = pk2(s[2 * 33], s[3 * 33]); o.z = pk2(s[4 * 33], s[5 * 33]); o.w = pk2(s[6 * 33], s[7 * 33]);
        *(GAS v4u*)(WT + (size_t)(rbase + n) * K + k0 + 8 * c) = o; }
    LDS_WAIT(); asm volatile("" ::: "memory");
}
__device__ __forceinline__ void ln_row(const float* xrow, bool zero_in, const float* g, const float* b, bf16* ob, float* of, float* st, int lane) {
    const GAS f32x4* xr = (const GAS f32x4*)xrow + lane;
    f32x4 v[8]; float s = 0.f;
#pragma unroll
    for (int j = 0; j < 8; ++j) { v[j] = zero_in ? (f32x4){0.f, 0.f, 0.f, 0.f} : xr[64 * j]; s += (v[j].x + v[j].y) + (v[j].z + v[j].w); }
    const float mean = wave_sum(s) * (1.f / DM); float s2 = 0.f;
#pragma unroll
    for (int j = 0; j < 8; ++j) { v[j] = v[j] - mean; s2 += (v[j].x * v[j].x + v[j].y * v[j].y) + (v[j].z * v[j].z + v[j].w * v[j].w); }
    const float rstd = 1.f / sqrtf(wave_sum(s2) * (1.f / DM) + 1e-5f);
#pragma unroll
    for (int j = 0; j < 8; ++j) {
        const f32x4 gv = *((const GAS f32x4*)g + lane + 64 * j), bv = *((const GAS f32x4*)b + lane + 64 * j);
        const f32x4 y = v[j] * rstd * gv + bv;
        if (ob) *((GAS v2u*)ob + lane + 64 * j) = (v2u){pk2(y.x, y.y), pk2(y.z, y.w)};
        if (of) *((GAS f32x4*)of + lane + 64 * j) = y;
    }
    if (st && lane == 0) { st[0] = mean; st[1] = rstd; }
}

#define TR4(d0, d1, d2, d3, base, o0, o1, o2, o3) asm volatile( \
    "ds_read_b64_tr_b16 %0, %4 offset:%5\n\tds_read_b64_tr_b16 %1, %4 offset:%6\n\tds_read_b64_tr_b16 %2, %4 offset:%7\n\tds_read_b64_tr_b16 %3, %4 offset:%8\n\ts_waitcnt lgkmcnt(0)" \
    : "=&v"(d0), "=&v"(d1), "=&v"(d2), "=&v"(d3) : "v"(base), "i"(o0), "i"(o1), "i"(o2), "i"(o3) : "memory")
#define TR8(d0, d1, d2, d3, d4, d5, d6, d7, base, o0, o1, o2, o3, o4, o5, o6, o7) asm volatile( \
    "ds_read_b64_tr_b16 %0, %8 offset:%9\n\tds_read_b64_tr_b16 %1, %8 offset:%10\n\tds_read_b64_tr_b16 %2, %8 offset:%11\n\tds_read_b64_tr_b16 %3, %8 offset:%12\n\t" \
    "ds_read_b64_tr_b16 %4, %8 offset:%13\n\tds_read_b64_tr_b16 %5, %8 offset:%14\n\tds_read_b64_tr_b16 %6, %8 offset:%15\n\tds_read_b64_tr_b16 %7, %8 offset:%16\n\ts_waitcnt lgkmcnt(0)" \
    : "=&v"(d0), "=&v"(d1), "=&v"(d2), "=&v"(d3), "=&v"(d4), "=&v"(d5), "=&v"(d6), "=&v"(d7) \
    : "v"(base), "i"(o0), "i"(o1), "i"(o2), "i"(o3), "i"(o4), "i"(o5), "i"(o6), "i"(o7) : "memory")
__device__ __forceinline__ bf16x8 cat4(bf16x4 lo, bf16x4 hi) { bf16x8 r; r[0] = lo[0]; r[1] = lo[1]; r[2] = lo[2]; r[3] = lo[3]; r[4] = hi[0]; r[5] = hi[1]; r[6] = hi[2]; r[7] = hi[3]; return r; }
#define MFMA16(a, b, c) __builtin_amdgcn_mfma_f32_16x16x32_bf16((a), (b), (c), 0, 0, 0)

constexpr int HQS = 272, HVS = 80;
constexpr int H_QD = 0, H_KD = H_QD + 64 * HQS, H_V = H_KD + 64 * HQS, H_SB = H_V + 64 * HVS, H_EL = H_SB + 32 * HQS, H_TOT = H_EL + 512, H_END = H_TOT + 16 * 128 * 4;
static_assert(H_END <= RING_BYTES, "hgrn lds");
__device__ __forceinline__ void hgrn_scan(LAS unsigned char* lds, const bf16* __restrict__ PROJ, const float* __restrict__ LOGF, float* __restrict__ HGO, int h, int j, int cb, int ce) {
    int tid_ = threadIdx.x; asm volatile("" : "+v"(tid_));
    const int tid = tid_, lane = tid & 63, w = __builtin_amdgcn_readfirstlane(tid >> 6);
    const int r16 = lane & 15, q4 = lane >> 4, tq = w >> 1, vh = w & 1, kt0 = 2 * (w >> 1);
    const int a_ = (lane & 15) >> 2, p_ = lane & 3;
    const int cg = tid & 31, rg = tid >> 5, vs = tid >> 3, vq = tid & 7;
    const unsigned lbase = (unsigned)(size_t)lds;
    f32x4 S[2]; S[0] = (f32x4){0.f, 0.f, 0.f, 0.f}; S[1] = S[0];
    f32x4 lf[4]; v2u qn[4], kn[4]; v2u vn;
#define H_LOAD(cc) do { const int t0_ = (cc) * 64; _Pragma("unroll") for (int i = 0; i < 4; ++i) { const size_t row_ = (size_t)(t0_ + 4 * rg + i); \
        lf[i] = *(const f32x4*)(LOGF + row_ * 1024 + h * 128 + 4 * cg); qn[i] = *(const v2u*)(PROJ + row_ * NPROJ + h * 128 + 4 * cg); kn[i] = *(const v2u*)(PROJ + row_ * NPROJ + 1024 + h * 128 + 4 * cg); } \
        vn = *(const v2u*)(PROJ + (size_t)(t0_ + vs) * NPROJ + 2048 + h * 128 + 32 * j + 4 * vq); } while (0)
    H_LOAD(cb);
    for (int c = cb; c < ce; ++c) {
        const int t0 = c * 64;
        f32x4 cs[4]; f32x4 run = (f32x4){0.f, 0.f, 0.f, 0.f};
#pragma unroll
        for (int i = 0; i < 4; ++i) { run = run + lf[i]; cs[i] = run; }
        *(LAS f32x4*)(lds + H_TOT + (rg * 128 + 4 * cg) * 4) = run;
        __syncthreads();
        f32x4 off = (f32x4){0.f, 0.f, 0.f, 0.f}, last = off;
#pragma unroll
        for (int r2 = 0; r2 < 16; ++r2) { const f32x4 tv = *(const LAS f32x4*)(lds + H_TOT + (r2 * 128 + 4 * cg) * 4); last = last + tv; if (r2 < rg) off = off + tv; }
#pragma unroll
        for (int i = 0; i < 4; ++i) {
            const f32x4 cum = off + cs[i];
            const float q0 = __uint_as_float(qn[i].x << 16), q1 = __uint_as_float(qn[i].x & 0xffff0000u), q2 = __uint_as_float(qn[i].y << 16), q3 = __uint_as_float(qn[i].y & 0xffff0000u);
            const float k0 = __uint_as_float(kn[i].x << 16), k1 = __uint_as_float(kn[i].x & 0xffff0000u), k2 = __uint_as_float(kn[i].y << 16), k3 = __uint_as_float(kn[i].y & 0xffff0000u);
            *(LAS v2u*)(lds + H_QD + (4 * rg + i) * HQS + 8 * cg) = (v2u){pk2(q0 * fexp(cum[0]), q1 * fexp(cum[1])), pk2(q2 * fexp(cum[2]), q3 * fexp(cum[3]))};
            *(LAS v2u*)(lds + H_KD + (4 * rg + i) * HQS + 8 * cg) = (v2u){pk2(k0 * fexp(-cum[0]), k1 * fexp(-cum[1])), pk2(k2 * fexp(-cum[2]), k3 * fexp(-cum[3]))};
        }
        if (rg == 0) *(LAS f32x4*)(lds + H_EL + 16 * cg) = (f32x4){fexp(last[0]), fexp(last[1]), fexp(last[2]), fexp(last[3])};
        *(LAS v2u*)(lds + H_V + vs * HVS + vq * 8) = vn;
#pragma unroll
        for (int u = 0; u < 2; ++u)
            *(LAS v2u*)(lds + H_SB + (16 * vh + r16) * HQS + (16 * (kt0 + u) + 4 * q4) * 2) = (v2u){pk2(S[u][0], S[u][1]), pk2(S[u][2], S[u][3])};
        __syncthreads();
        if (c + 1 < ce) H_LOAD(c + 1);
        bf16x8 qf[4];
#pragma unroll
        for (int kb = 0; kb < 4; ++kb) qf[kb] = *(const LAS bf16x8*)(lds + H_QD + (16 * tq + r16) * HQS + (32 * kb + 8 * q4) * 2);
        f32x4 o = (f32x4){0.f, 0.f, 0.f, 0.f};
#pragma unroll
        for (int kb = 0; kb < 4; ++kb) {
            const bf16x8 b = *(const LAS bf16x8*)(lds + H_SB + (16 * vh + r16) * HQS + (32 * kb + 8 * q4) * 2);
            o = MFMA16(qf[kb], b, o);
        }
        bf16x4 v0, v1, v2, v3;
        { const unsigned va = lbase + H_V + (4 * q4 + a_) * HVS + (16 * vh + 4 * p_) * 2; TR4(v0, v1, v2, v3, va, 0, 16 * HVS, 32 * HVS, 48 * HVS); }
#pragma unroll
        for (int p = 0; p < 2; ++p) {
            if (2 * p <= tq) {
                f32x4 xa = (f32x4){0.f, 0.f, 0.f, 0.f}, xb = xa;
#pragma unroll
                for (int kb = 0; kb < 4; ++kb) {
                    const bf16x8 a = *(const LAS bf16x8*)(lds + H_KD + (32 * p + r16) * HQS + (32 * kb + 8 * q4) * 2);
                    xa = MFMA16(a, qf[kb], xa);
                }
                if (2 * p == tq) {
#pragma unroll
                    for (int i = 0; i < 4; ++i) if (4 * q4 + i > r16) xa[i] = 0.f;
                }
                if (2 * p + 1 <= tq) {
#pragma unroll
                    for (int kb = 0; kb < 4; ++kb) {
                        const bf16x8 a = *(const LAS bf16x8*)(lds + H_KD + (32 * p + 16 + r16) * HQS + (32 * kb + 8 * q4) * 2);
                        xb = MFMA16(a, qf[kb], xb);
                    }
                    if (2 * p + 1 == tq) {
#pragma unroll
                        for (int i = 0; i < 4; ++i) if (4 * q4 + i > r16) xb[i] = 0.f;
                    }
                }
                bf16x8 pa;
                pa[0] = (short)f2bf(xa[0]); pa[1] = (short)f2bf(xa[1]); pa[2] = (short)f2bf(xa[2]); pa[3] = (short)f2bf(xa[3]);
                pa[4] = (short)f2bf(xb[0]); pa[5] = (short)f2bf(xb[1]); pa[6] = (short)f2bf(xb[2]); pa[7] = (short)f2bf(xb[3]);
                o = MFMA16(pa, p == 0 ? cat4(v0, v1) : cat4(v2, v3), o);
            }
        }
        if (c > 0) {
#pragma unroll
            for (int i = 0; i < 4; ++i) HGO[(size_t)(t0 - PADM + 16 * tq + 4 * q4 + i) * 1024 + h * 128 + 32 * j + 16 * vh + r16] = o[i];
        }
        {
            bf16x4 b0, b1, b2, b3, a0, a1, a2, a3, a4, a5, a6, a7;
            const unsigned va = lbase + H_V + (8 * q4 + a_) * HVS + (16 * vh + 4 * p_) * 2;
            TR4(b0, b1, b2, b3, va, 0, 4 * HVS, 32 * HVS, 36 * HVS);
            const unsigned ka = lbase + H_KD + (8 * q4 + a_) * HQS + (16 * kt0 + 4 * p_) * 2;
            TR8(a0, a1, a2, a3, a4, a5, a6, a7, ka, 0, 4 * HQS, 32 * HQS, 36 * HQS, 32, 4 * HQS + 32, 32 * HQS + 32, 36 * HQS + 32);
            S[0] = MFMA16(cat4(a0, a1), cat4(b0, b1), S[0]); S[0] = MFMA16(cat4(a2, a3), cat4(b2, b3), S[0]);
            S[1] = MFMA16(cat4(a4, a5), cat4(b0, b1), S[1]); S[1] = MFMA16(cat4(a6, a7), cat4(b2, b3), S[1]);
#pragma unroll
            for (int u = 0; u < 2; ++u) { const f32x4 el = *(const LAS f32x4*)(lds + H_EL + (16 * (kt0 + u) + 4 * q4) * 4); S[u] = S[u] * el; }
        }
    }
#undef H_LOAD
    __syncthreads();
}

constexpr int RQS = 528, RVS = 80;
constexpr int R_Q = 0, R_K = R_Q + 64 * RQS, R_V = R_K + 64 * RQS, R_VD = R_V + 64 * RVS, R_RB = R_VD + 64 * RVS, R_END = R_RB + 32 * RQS;
static_assert(R_END <= RING_BYTES, "ret lds");
__device__ __forceinline__ void ret_scan(LAS unsigned char* lds, const bf16* __restrict__ PROJ, float* __restrict__ RETO, int h, int j, int cb, int ce) {
    int tid_ = threadIdx.x; asm volatile("" : "+v"(tid_));
    const int tid = tid_, lane = tid & 63, w = __builtin_amdgcn_readfirstlane(tid >> 6);
    const int r16 = lane & 15, q4 = lane >> 4, tq = w >> 1, vh = w & 1, kt0 = 4 * (w >> 1);
    const int a_ = (lane & 15) >> 2, p_ = lane & 3, vs = tid >> 3, vq = tid & 7;
    const unsigned lbase = (unsigned)(size_t)lds;
    const float l2g = log2f(1.0f - exp2f(-5.0f - (float)h));
    const float g64 = __builtin_amdgcn_exp2f(64.0f * l2g);
    f32x4 R[4];
#pragma unroll
    for (int u = 0; u < 4; ++u) R[u] = (f32x4){0.f, 0.f, 0.f, 0.f};
    v4u qn[4], kn[4]; v2u vn;
#define R_LOAD(cc) do { const int t0_ = (cc) * 64; _Pragma("unroll") for (int i = 0; i < 4; ++i) { const int id_ = tid + 512 * i, row_ = id_ >> 5, ch_ = id_ & 31; \
        qn[i] = *(const v4u*)(PROJ + (size_t)(t0_ + row_) * NPROJ + 4096 + h * 256 + ch_ * 8); kn[i] = *(const v4u*)(PROJ + (size_t)(t0_ + row_) * NPROJ + 5120 + h * 256 + ch_ * 8); } \
        vn = *(const v2u*)(PROJ + (size_t)(t0_ + vs) * NPROJ + 6144 + h * 256 + 32 * j + 4 * vq); } while (0)
    R_LOAD(cb);
    for (int c = cb; c < ce; ++c) {
        const int t0 = c * 64;
        __syncthreads();
#pragma unroll
        for (int i = 0; i < 4; ++i) { const int id = tid + 512 * i, row = id >> 5, ch = id & 31;
            *(LAS v4u*)(lds + R_Q + row * RQS + ch * 16) = qn[i]; *(LAS v4u*)(lds + R_K + row * RQS + ch * 16) = kn[i]; }
        { *(LAS v2u*)(lds + R_V + vs * RVS + vq * 8) = vn;
          const float dec = __builtin_amdgcn_exp2f((float)(63 - vs) * l2g);
          const float x0 = __uint_as_float(vn.x << 16) * dec, x1 = __uint_as_float(vn.x & 0xffff0000u) * dec, x2 = __uint_as_float(vn.y << 16) * dec, x3 = __uint_as_float(vn.y & 0xffff0000u) * dec;
          *(LAS v2u*)(lds + R_VD + vs * RVS + vq * 8) = (v2u){pk2(x0, x1), pk2(x2, x3)}; }
#pragma unroll
        for (int u = 0; u < 4; ++u)
            *(LAS v2u*)(lds + R_RB + (16 * vh + r16) * RQS + (16 * (kt0 + u) + 4 * q4) * 2) = (v2u){pk2(R[u][0], R[u][1]), pk2(R[u][2], R[u][3])};
        __syncthreads();
        if (c + 1 < ce) R_LOAD(c + 1);
        bf16x8 qf[8];
#pragma unroll
        for (int kb = 0; kb < 8; ++kb) qf[kb] = *(const LAS bf16x8*)(lds + R_Q + (16 * tq + r16) * RQS + (32 * kb + 8 * q4) * 2);
        f32x4 o = (f32x4){0.f, 0.f, 0.f, 0.f};
#pragma unroll
        for (int kb = 0; kb < 8; ++kb) {
            const bf16x8 b = *(const LAS bf16x8*)(lds + R_RB + (16 * vh + r16) * RQS + (32 * kb + 8 * q4) * 2);
            o = MFMA16(qf[kb], b, o);
        }
#pragma unroll
        for (int i = 0; i < 4; ++i) o[i] *= __builtin_amdgcn_exp2f((float)(16 * tq + 4 * q4 + i + 1) * l2g);
        bf16x4 v0, v1, v2, v3;
        { const unsigned va = lbase + R_V + (4 * q4 + a_) * RVS + (16 * vh + 4 * p_) * 2; TR4(v0, v1, v2, v3, va, 0, 16 * RVS, 32 * RVS, 48 * RVS); }
#pragma unroll
        for (int p = 0; p < 2; ++p) {
            if (2 * p <= tq) {
                f32x4 xa = (f32x4){0.f, 0.f, 0.f, 0.f}, xb = xa;
#pragma unroll
                for (int kb = 0; kb < 8; ++kb) {
                    const bf16x8 a = *(const LAS bf16x8*)(lds + R_K + (32 * p + r16) * RQS + (32 * kb + 8 * q4) * 2);
                    xa = MFMA16(a, qf[kb], xa);
                }
#pragma unroll
                for (int i = 0; i < 4; ++i) { const int rel = (16 * tq + r16) - (32 * p + 4 * q4 + i); xa[i] = rel >= 0 ? xa[i] * __builtin_amdgcn_exp2f((float)rel * l2g) : 0.f; }
                if (2 * p + 1 <= tq) {
#pragma unroll
                    for (int kb = 0; kb < 8; ++kb) {
                        const bf16x8 a = *(const LAS bf16x8*)(lds + R_K + (32 * p + 16 + r16) * RQS + (32 * kb + 8 * q4) * 2);
                        xb = MFMA16(a, qf[kb], xb);
                    }
#pragma unroll
                    for (int i = 0; i < 4; ++i) { const int rel = (16 * tq + r16) - (32 * p + 16 + 4 * q4 + i); xb[i] = rel >= 0 ? xb[i] * __builtin_amdgcn_exp2f((float)rel * l2g) : 0.f; }
                }
                bf16x8 pa;
                pa[0] = (short)f2bf(xa[0]); pa[1] = (short)f2bf(xa[1]); pa[2] = (short)f2bf(xa[2]); pa[3] = (short)f2bf(xa[3]);
                pa[4] = (short)f2bf(xb[0]); pa[5] = (short)f2bf(xb[1]); pa[6] = (short)f2bf(xb[2]); pa[7] = (short)f2bf(xb[3]);
                o = MFMA16(pa, p == 0 ? cat4(v0, v1) : cat4(v2, v3), o);
            }
        }
        if (c > 0) {
#pragma unroll
            for (int i = 0; i < 4; ++i) RETO[(size_t)(t0 - PADM + 16 * tq + 4 * q4 + i) * 1024 + h * 256 + 32 * j + 16 * vh + r16] = o[i];
        }
        {
            bf16x4 b0, b1, b2, b3;
            const unsigned va = lbase + R_VD + (8 * q4 + a_) * RVS + (16 * vh + 4 * p_) * 2;
            TR4(b0, b1, b2, b3, va, 0, 4 * RVS, 32 * RVS, 36 * RVS);
            const bf16x8 vb0 = cat4(b0, b1), vb1 = cat4(b2, b3);
            const unsigned ka = lbase + R_K + (8 * q4 + a_) * RQS + (16 * kt0 + 4 * p_) * 2;
#pragma unroll
            for (int up = 0; up < 2; ++up) {
                bf16x4 a0, a1, a2, a3, a4, a5, a6, a7;
                if (up == 0) TR8(a0, a1, a2, a3, a4, a5, a6, a7, ka, 0, 4 * RQS, 32 * RQS, 36 * RQS, 32, 4 * RQS + 32, 32 * RQS + 32, 36 * RQS + 32);
                else         TR8(a0, a1, a2, a3, a4, a5, a6, a7, ka, 64, 4 * RQS + 64, 32 * RQS + 64, 36 * RQS + 64, 96, 4 * RQS + 96, 32 * RQS + 96, 36 * RQS + 96);
                R[2 * up] = R[2 * up] * g64; R[2 * up + 1] = R[2 * up + 1] * g64;
                R[2 * up] = MFMA16(cat4(a0, a1), vb0, R[2 * up]); R[2 * up] = MFMA16(cat4(a2, a3), vb1, R[2 * up]);
                R[2 * up + 1] = MFMA16(cat4(a4, a5), vb0, R[2 * up + 1]); R[2 * up + 1] = MFMA16(cat4(a6, a7), vb1, R[2 * up + 1]);
            }
        }
    }
#undef R_LOAD
    __syncthreads();
}

__device__ __forceinline__ void meta_proj(Frame& F, const bf16* __restrict__ WINT, const bf16* __restrict__ HM, bf16* PROJ, float* LOGF, const float* LB, const float* RC, const float* RS) {
    LAS unsigned char* hm = F.lds;
    for (int i = F.tid; i < 16 * 2048 * 2 / 16; i += 512) *(LAS v4u*)(hm + 16 * i) = *((const v4u*)HM + i);
    __syncthreads();
    const int r = F.tid >> 5, ci = F.tid & 31, t = PADF + r;
    for (int grp = blockIdx.x; grp < 256; grp += F.G) {
        int col; int mode;
        if (grp < 128) { col = 32 * grp + ci; mode = col >> 10; }
        else if (grp < 192) { const int g2 = grp - 128, region = g2 >> 3, jj = g2 & 7; col = 4096 + region * 256 + 16 * jj + (ci & 15) + 128 * (ci >> 4); mode = 4 + (region >> 2); }
        else { col = 6144 + 32 * (grp - 192) + ci; mode = col >> 10; }
        const v4u* wrow = (const v4u*)(WINT + (size_t)col * DM);
        float acc = 0.f;
#pragma unroll 4
        for (int k8 = 0; k8 < 256; ++k8) {
            const v4u wv = wrow[k8]; const v4u hv = *(const LAS v4u*)(hm + r * 4096 + 16 * k8);
#pragma unroll
            for (int e = 0; e < 4; ++e) {
                acc = fmaf(__uint_as_float(wv[e] << 16), __uint_as_float(hv[e] << 16), acc);
                acc = fmaf(__uint_as_float(wv[e] & 0xffff0000u), __uint_as_float(hv[e] & 0xffff0000u), acc);
            }
        }
        const float partner = __shfl_xor(acc, 16);
        float o = acc;
        if (mode == 0) o = silu_f(acc) * 0.08838834764831845f;
        else if (mode == 1) { const float lb = LB[col - 1024]; const float f = lb + (1.0f - lb) * sigmoid_f(acc); LOGF[(size_t)t * 1024 + col - 1024] = logf(f); o = 1.0f - f; }
        else if (mode == 3 || mode == 7) o = silu_f(acc);
        else if (mode == 4 || mode == 5) {
            const int hi = ci >> 4, d = (col - 4096) & 127;
            const float cs = RC[(size_t)t * 128 + d], sn = RS[(size_t)t * 128 + d];
            const float x1 = hi ? partner : acc, x2 = hi ? acc : partner;
            o = hi ? (x1 * sn + x2 * cs) : (x1 * cs - x2 * sn);
            if (mode == 5) o *= 0.0625f;
        }
        PROJ[(size_t)t * NPROJ + col] = (bf16)f2bf(o);
    }
    __syncthreads();
}

struct Args { const float* in[17]; float* out; unsigned char* ws; };
__global__ void __launch_bounds__(NWAVES * 64, 2) mega_fwd(Args args) {
    extern __shared__ __attribute__((aligned(16))) unsigned char lds_raw[];
    Frame F;
    F.lds = (LAS unsigned char*)lds_raw;
    F.MISC = (volatile LAS unsigned*)(F.lds + MISC_OFF);
#define REFRESH() do { int t_ = threadIdx.x; asm volatile("" : "+v"(t_)); F.tid = t_; F.lane = t_ & 63; } while (0)
    REFRESH(); F.wave = __builtin_amdgcn_readfirstlane(F.tid >> 6); F.G = gridDim.x;
    F.x = args.in[0]; F.meta = args.in[1]; F.ln_in_g = args.in[2]; F.ln_in_b = args.in[3]; F.hlb = args.in[4]; F.w_in = args.in[5]; F.hg_ng = args.in[6]; F.ret_ng = args.in[7];
    F.ret_nb = args.in[8]; F.w_out = args.in[9]; F.ln1_g = args.in[10]; F.ln1_b = args.in[11]; F.w_gate = args.in[12]; F.w_up = args.in[13]; F.w_down = args.in[14];
    F.ln2_g = args.in[15]; F.ln2_b = args.in[16]; F.out = args.out; F.ws = args.ws;
    unsigned char* ws = args.ws;
    float* LB = (float*)(ws + WS_LB); float* ST0 = (float*)(ws + WS_ST0); float* ST1 = (float*)(ws + WS_ST1); bf16* HM = (bf16*)(ws + WS_HM);
    bf16* WINT = (bf16*)(ws + WS_WIN); bf16* WOUTT = (bf16*)(ws + WS_WOUT); bf16* WDOWNT = (bf16*)(ws + WS_WDOWN); bf16* WGUT = (bf16*)(ws + WS_WGU);
    bf16* H0B = (bf16*)(ws + WS_H0B); bf16* MIX = (bf16*)(ws + WS_MIX); bf16* H1B = (bf16*)(ws + WS_H1B); bf16* PROJ = (bf16*)(ws + WS_PROJ);
    float* Z = (float*)(ws + WS_Z); bf16* ACT = (bf16*)(ws + WS_ACT); float* LOGF = (float*)(ws + WS_LOGF);
    float* RC = (float*)((unsigned char*)args.out + DO_RC); float* RS = (float*)((unsigned char*)args.out + DO_RS);
    float* HGO = args.out; float* RETO = args.out + (size_t)SEQ * 1024;
    for (int u = F.tid; u < (LDS_BYTES - LDSCTL_OFF) / 4; u += NWAVES * 64) ((LAS unsigned*)(F.lds + LDSCTL_OFF))[u] = 0u;
    __syncthreads();
    XcdBarrier bar = xcd_barrier_post((unsigned*)(ws + WS_CTL) + CW_BAR, F.MISC + 8);
    const int gw = blockIdx.x * NWAVES + F.wave, NGW = F.G * NWAVES;
#ifdef PROBE_A
    int n_stamp = 0;
#define STAMP() do { if (blockIdx.x == 0 && F.tid == 0) ((unsigned long long*)(ws + WS_CTL + 32768))[n_stamp] = __builtin_amdgcn_s_memrealtime(); ++n_stamp; } while (0)
#else
#define STAMP() do {} while (0)
#endif
    STAMP();

    {
        LAS float* scr = (LAS float*)(F.lds + RING_OFF + F.wave * 16384);
        constexpr int I_IN = (DM / 64) * (NPROJ / 32);
        for (int it = gw; it < I_IN; it += NGW) transpose_item<0>(F.w_in, DM, NPROJ, WINT, scr, it, F.lane);
        for (int m = gw; m < SEQ; m += NGW) ln_row(F.x + (size_t)m * DM, false, F.ln_in_g, F.ln_in_b, H0B + (size_t)m * DM, nullptr, ST0 + 2 * m, F.lane);
        if (gw < 16) ln_row(F.meta + (size_t)gw * DM, false, F.ln_in_g, F.ln_in_b, HM + (size_t)gw * DM, nullptr, nullptr, F.lane);
        for (int t = gw; t < LT; t += NGW) {
#pragma unroll
            for (int hh = 0; hh < 2; ++hh) {
                const int d = F.lane + 64 * hh;
                const float invf = (float)pow(10000.0, -(double)d / 128.0);
                const float ang = (float)(t - PADF) * invf;
                RC[(size_t)t * 128 + d] = (float)cos((double)ang); RS[(size_t)t * 128 + d] = (float)sin((double)ang);
            }
        }
        if (gw < 16) { const int jx = gw * 64 + F.lane; LB[jx] = 1.0f / (1.0f + expf(F.hlb[1024 + jx] - F.hlb[jx])); }
        for (int i = blockIdx.x * 512 + F.tid; i < PADF * NPROJ * 2 / 16; i += F.G * 512) *((GAS v4u*)PROJ + i) = (v4u){0u, 0u, 0u, 0u};
        for (int i = blockIdx.x * 512 + F.tid; i < PADF * 1024 * 4 / 16; i += F.G * 512) *((GAS v4u*)LOGF + i) = (v4u){0u, 0u, 0u, 0u};
    }
    xcd_barrier(bar); STAMP(); REFRESH();

    {
        meta_proj(F, WINT, HM, PROJ, LOGF, LB, RC, RS);
        pg8::Gemm g{H0B, WINT, SEQ, NPROJ, DM}; pg8::StaticOrder S; S.init(SEQ, NPROJ, F.G, (int)blockIdx.x);
        pg8::EpiProj E{PROJ, LOGF, LB, RC, RS};
        pg8::gemm_phase<pg8::EpiProj, pg8::StaticOrder, true, true>(F.lds + RING_OFF, g, S, E);
    }
    xcd_barrier(bar); STAMP(); REFRESH();

    {
        const int nscan = F.G >= 128 ? 64 : 0;
        if (nscan == 0 || (int)blockIdx.x < 64) {
            for (int it = blockIdx.x; it < 64; it += (nscan ? 64 : F.G)) {
                if (it < 32) hgrn_scan(F.lds, PROJ, LOGF, HGO, it >> 2, it & 3, 0, NCHUNK);
                else ret_scan(F.lds, PROJ, RETO, (it - 32) >> 3, (it - 32) & 7, 0, NCHUNK);
            }
        }
        if (nscan == 0 || (int)blockIdx.x >= 64) {
            LAS float* scr = (LAS float*)(F.lds + RING_OFF + F.wave * 16384);
            const int cw = (nscan ? ((int)blockIdx.x - 64) : (int)blockIdx.x) * NWAVES + F.wave, NCW = (nscan ? F.G - 64 : F.G) * NWAVES;
            constexpr int I_O = (DM / 64) * (DM / 32), I_D = (DFF / 64) * (DM / 32), I_G = (DM / 64) * (DFF / 32);
            for (int it = cw; it < I_O + I_D + 2 * I_G; it += NCW) {
                int r = it;
                if (r < I_O) { transpose_item<0>(F.w_out, DM, DM, WOUTT, scr, r, F.lane); continue; } r -= I_O;
                if (r < I_D) { transpose_item<0>(F.w_down, DFF, DM, WDOWNT, scr, r, F.lane); continue; } r -= I_D;
                if (r < I_G) { transpose_item<1>(F.w_gate, DM, DFF, WGUT, scr, r, F.lane); continue; } r -= I_G;
                transpose_item<2>(F.w_up, DM, DFF, WGUT, scr, r, F.lane);
            }
        }
    }
    xcd_barrier(bar); STAMP(); REFRESH();

    for (int r = gw; r < SEQ; r += NGW) {
        const int t = r + PADM, c0 = 16 * F.lane;
        {
            f32x4 o[4]; float s = 0.f;
#pragma unroll
            for (int i = 0; i < 4; ++i) { o[i] = *(const GAS f32x4*)(HGO + (size_t)r * 1024 + c0 + 4 * i); s += (o[i].x * o[i].x + o[i].y * o[i].y) + (o[i].z * o[i].z + o[i].w * o[i].w); }
            s += __shfl_xor(s, 1); s += __shfl_xor(s, 2); s += __shfl_xor(s, 4);
            const float rs = 1.0f / sqrtf(s * (1.f / 128.f) + 1e-6f);
            const v4u g0 = *(const GAS v4u*)(PROJ + (size_t)t * NPROJ + 3072 + c0), g1 = *(const GAS v4u*)(PROJ + (size_t)t * NPROJ + 3072 + c0 + 8);
            unsigned wout[8];
#pragma unroll
            for (int i = 0; i < 4; ++i) {
                const f32x4 ng = *(const GAS f32x4*)(F.hg_ng + c0 + 4 * i);
                const unsigned ga = (i < 2) ? g0[2 * i] : g1[2 * (i - 2)], gb = (i < 2) ? g0[2 * i + 1] : g1[2 * (i - 2) + 1];
                const float y0 = o[i].x * rs * ng.x * __uint_as_float(ga << 16), y1 = o[i].y * rs * ng.y * __uint_as_float(ga & 0xffff0000u);
                const float y2 = o[i].z * rs * ng.z * __uint_as_float(gb << 16), y3 = o[i].w * rs * ng.w * __uint_as_float(gb & 0xffff0000u);
                wout[2 * i] = pk2(y0, y1); wout[2 * i + 1] = pk2(y2, y3);
            }
            *(GAS v4u*)(MIX + (size_t)r * DM + c0) = (v4u){wout[0], wout[1], wout[2], wout[3]};
            *(GAS v4u*)(MIX + (size_t)r * DM + c0 + 8) = (v4u){wout[4], wout[5], wout[6], wout[7]};
        }
        {
            f32x4 o[4]; float s = 0.f;
#pragma unroll
            for (int i = 0; i < 4; ++i) { o[i] = *(const GAS f32x4*)(RETO + (size_t)r * 1024 + c0 + 4 * i); s += (o[i].x + o[i].y) + (o[i].z + o[i].w); }
            s += __shfl_xor(s, 1); s += __shfl_xor(s, 2); s += __shfl_xor(s, 4); s += __shfl_xor(s, 8);
            const float mu = s * (1.f / 256.f); float q = 0.f;
#pragma unroll
            for (int i = 0; i < 4; ++i) { o[i] = o[i] - mu; q += (o[i].x * o[i].x + o[i].y * o[i].y) + (o[i].z * o[i].z + o[i].w * o[i].w); }
            q += __shfl_xor(q, 1); q += __shfl_xor(q, 2); q += __shfl_xor(q, 4); q += __shfl_xor(q, 8);
            const float rs = 1.0f / sqrtf(q * (1.f / 256.f) + 1e-6f);
            const v4u g0 = *(const GAS v4u*)(PROJ + (size_t)t * NPROJ + 7168 + c0), g1 = *(const GAS v4u*)(PROJ + (size_t)t * NPROJ + 7168 + c0 + 8);
            unsigned wout[8];
#pragma unroll
            for (int i = 0; i < 4; ++i) {
                const f32x4 ng = *(const GAS f32x4*)(F.ret_ng + c0 + 4 * i), nb = *(const GAS f32x4*)(F.ret_nb + c0 + 4 * i);
                const unsigned ga = (i < 2) ? g0[2 * i] : g1[2 * (i - 2)], gb = (i < 2) ? g0[2 * i + 1] : g1[2 * (i - 2) + 1];
                const float y0 = (o[i].x * rs * ng.x + nb.x) * __uint_as_float(ga << 16), y1 = (o[i].y * rs * ng.y + nb.y) * __uint_as_float(ga & 0xffff0000u);
                const float y2 = (o[i].z * rs * ng.z + nb.z) * __uint_as_float(gb << 16), y3 = (o[i].w * rs * ng.w + nb.w) * __uint_as_float(gb & 0xffff0000u);
                wout[2 * i] = pk2(y0, y1); wout[2 * i + 1] = pk2(y2, y3);
            }
            *(GAS v4u*)(MIX + (size_t)r * DM + 1024 + c0) = (v4u){wout[0], wout[1], wout[2], wout[3]};
            *(GAS v4u*)(MIX + (size_t)r * DM + 1024 + c0 + 8) = (v4u){wout[4], wout[5], wout[6], wout[7]};
        }
    }
    xcd_barrier(bar); STAMP(); REFRESH();

    {
        pg8::Gemm g{MIX, WOUTT, SEQ, DM, DM}; pg8::StaticOrder S; S.init(SEQ, DM, F.G, (int)blockIdx.x);
        pg8::EpiResid E{F.x, ST0, F.ln_in_g, F.ln_in_b, Z};
        pg8::gemm_phase<pg8::EpiResid, pg8::StaticOrder, true, true>(F.lds + RING_OFF, g, S, E);
    }
    xcd_barrier(bar); STAMP(); REFRESH();
    for (int m = gw; m < SEQ; m += NGW) ln_row(Z + (size_t)m * DM, false, F.ln1_g, F.ln1_b, H1B + (size_t)m * DM, nullptr, ST1 + 2 * m, F.lane);
    xcd_barrier(bar); STAMP(); REFRESH();
    {
        pg8::Gemm g{H1B, WGUT, SEQ, 2 * DFF, DM}; pg8::StaticOrder S; S.init(SEQ, 2 * DFF, F.G, (int)blockIdx.x);
        pg8::EpiGU E{ACT};
        pg8::gemm_phase<pg8::EpiGU, pg8::StaticOrder, true, true>(F.lds + RING_OFF, g, S, E);
    }
    xcd_barrier(bar); STAMP(); REFRESH();
    {
        pg8::Gemm g{ACT, WDOWNT, SEQ, DM, DFF}; pg8::StaticOrder S; S.init(SEQ, DM, F.G, (int)blockIdx.x);
        pg8::EpiResid E{Z, ST1, F.ln1_g, F.ln1_b, F.out};
        pg8::gemm_phase<pg8::EpiResid, pg8::StaticOrder, true, true>(F.lds + RING_OFF, g, S, E);
    }
    xcd_barrier(bar); STAMP(); REFRESH();
    for (int m = gw; m < SEQ; m += NGW) ln_row(F.out + (size_t)m * DM, false, F.ln2_g, F.ln2_b, nullptr, F.out + (size_t)m * DM, nullptr, F.lane);
#ifdef PROBE_A
    xcd_barrier(bar); STAMP(); REFRESH();
    {
        const unsigned long long* ts = (const unsigned long long*)(ws + WS_CTL + 32768);
        const unsigned long long ta0 = __hip_atomic_load(ts + PROBE_A, RLX_AGENT), ta1 = __hip_atomic_load(ts + PROBE_A + 1, RLX_AGENT);
        const unsigned long long tb0 = __hip_atomic_load(ts + PROBE_B, RLX_AGENT), tb1 = __hip_atomic_load(ts + PROBE_B + 1, RLX_AGENT);
        const float a_us = (float)(ta1 - ta0) * 0.01f, b_us = (float)(tb1 - tb0) * 0.01f;
        if (blockIdx.x == 0 && F.tid == 0) F.out[0] += a_us * 0.1f;
        for (int i = blockIdx.x * 512 + F.tid; i < 512 * DM; i += F.G * 512) F.out[(size_t)4096 * DM + i] += b_us * 0.001f;
    }
#endif
}

extern "C" void kernel_launch(void* const* d_in, const int* in_sizes, int n_in, void* d_out, int out_size, void* d_ws, size_t ws_size, hipStream_t stream) {
    static int grid = 0;
    if (grid == 0) {
        if (n_in != 17 || out_size != SEQ * DM || ws_size < WS_END) { fprintf(stderr, "kernel_launch: unexpected shapes (n_in %d out %d ws %zu)\n", n_in, out_size, ws_size); grid = -1; return; }
        int dev = 0, cus = 0, per_cu = 0;
        if (hipGetDevice(&dev) != hipSuccess || hipDeviceGetAttribute(&cus, hipDeviceAttributeMultiprocessorCount, dev) != hipSuccess) { grid = -1; return; }
        if (hipFuncSetAttribute((const void*)mega_fwd, hipFuncAttributeMaxDynamicSharedMemorySize, LDS_BYTES) != hipSuccess) { fprintf(stderr, "kernel_launch: hipFuncSetAttribute failed\n"); grid = -1; return; }
        if (hipOccupancyMaxActiveBlocksPerMultiprocessor(&per_cu, (const void*)mega_fwd, NWAVES * 64, LDS_BYTES) != hipSuccess || per_cu < 1) { fprintf(stderr, "kernel_launch: occupancy query says %d\n", per_cu); (void)hipGetLastError(); per_cu = 1; }
        grid = cus * 1;
    }
    if (grid < 0) return;
    (void)hipMemsetAsync((char*)d_ws + WS_CTL, 0, CTL_ZERO_BYTES, stream);
    Args a{};
    for (int i = 0; i < 17; ++i) a.in[i] = (const float*)d_in[i];
    a.out = (float*)d_out; a.ws = (unsigned char*)d_ws;
    void* kargs[] = {&a};
    hipError_t e = hipLaunchCooperativeKernel((const void*)mega_fwd, dim3(grid), dim3(NWAVES * 64), kargs, LDS_BYTES, stream);
    if (e != hipSuccess) fprintf(stderr, "kernel_launch: cooperative launch failed: %s (grid %d)\n", hipGetErrorString(e), grid);
}
```

```cpp
#include <hip/hip_runtime.h>
#include <cstdio>
#include <cstdint>
#include <math.h>

namespace pg8 {
#define PG8_LAS __attribute__((address_space(3)))
typedef unsigned short bf16_t;
typedef short bf16x8 __attribute__((ext_vector_type(8)));
typedef float f32x4 __attribute__((ext_vector_type(4)));
typedef unsigned u32x4 __attribute__((ext_vector_type(4)));
constexpr int BM = 256, BK = 64, HALF = 128, HTB = HALF * BK * 2  , STAGE_BYTES = 8 * HTB, NXCD = 8, WGM = 8;

__host__ __device__ __forceinline__ int lds_byte(int r, int c) { const int st = (r >> 4) * 2 + (c >> 5), rr = r & 15, cc = c & 31, ob = rr * 64 + cc * 2; return st * 1024 + (ob ^ (((ob >> 9) & 1) << 5)); }
__host__ __device__ __forceinline__ void stage_rc(int b, int& R, int& C) { const int st = b / 1024, sb = b % 1024, swz = sb ^ (((sb >> 9) & 1) << 5); R = (st >> 1) * 16 + swz / 64; C = (st & 1) * 32 + (swz % 64) / 2; }
__host__ __device__ __forceinline__ int perm32(int rho) { const int n = rho >> 4, i = rho & 15; return 8 * (i >> 2) + 4 * n + (i & 3); }

struct Unit { int pm, pn; };
struct Gemm { const bf16_t* A; const bf16_t* Bt; int M, N, K; };

struct StaticOrder {
    int nM, nN, nwg, G, c;
    __host__ __device__ void init(int M, int N, int G_, int c_) { nM = M / BM; nN = N / BM; nwg = nM * nN; G = G_; c = c_; }
    __host__ __device__ bool next(int i, Unit& u) const {
        const long L = (long)i * G + c; if (L >= nwg) return false;
        int wgid = (int)L; { const int q = nwg / NXCD, r = nwg % NXCD, xcd = wgid % NXCD, off = wgid / NXCD; wgid = (xcd < r ? xcd * (q + 1) : r * (q + 1) + (xcd - r) * q) + off; }
        const int nig = WGM * nN, gid = wgid / nig, fm = gid * WGM, gsz = (nM - fm) < WGM ? (nM - fm) : WGM;
        u.pm = fm + ((wgid % nig) % gsz); u.pn = (wgid % nig) / gsz; return true;
    }
    __device__ __forceinline__ void a_ready(const Unit&) const {}
    __device__ __forceinline__ void done(const Unit&) const {}
};

__device__ __forceinline__ unsigned cvt_pk_bf16(float lo, float hi) { unsigned r; asm volatile("v_cvt_pk_bf16_f32 %0, %1, %2" : "=v"(r) : "v"(lo), "v"(hi)); return r; }
__device__ __forceinline__ float fexp(float x) { return __builtin_amdgcn_exp2f(x * 1.4426950408889634f); }
__device__ __forceinline__ float silu_f(float x) { return x * __builtin_amdgcn_rcpf(1.0f + fexp(-x)); }
__device__ __forceinline__ float sigmoid_f(float x) { return __builtin_amdgcn_rcpf(1.0f + fexp(-x)); }

constexpr int NPROJ = 8192, DM = 2048, DFF = 5632, PADM = 64;
constexpr float ALPHA = 1.18920711500272f;


struct EpiProj {
    static constexpr bool PERM = true, AFTER_DRAIN = false;
    bf16_t* PROJ; float* LOGF; const float* LB; const float* RC; const float* RS;
    __device__ __forceinline__ void operator()(const f32x4 (&acc)[2][2][4][2], const Unit& u, int wr, int wc, int fr, int fq) const {
        const int cgp = u.pn >> 2, row0 = u.pm * BM + wr * 64 + fr, cl = wc * 32 + 8 * fq;
        if (cgp == 4 || cgp == 5) {
            const float sc = (cgp == 5) ? 0.0625f : 1.0f;
#pragma unroll
            for (int ai = 0; ai < 2; ++ai)
#pragma unroll
                for (int m = 0; m < 4; ++m) {
                    const int t = row0 + ai * HALF + m * 16 + PADM;
                    u32x4 w1, w2;
#pragma unroll
                    for (int n = 0; n < 2; ++n) {
                        const f32x4 cs = *(const f32x4*)(RC + (size_t)t * 128 + cl + 4 * n), sn = *(const f32x4*)(RS + (size_t)t * 128 + cl + 4 * n);
                        const f32x4 x1 = acc[ai][0][m][n], x2 = acc[ai][1][m][n];
                        const f32x4 o1 = (x1 * cs - x2 * sn) * sc, o2 = (x1 * sn + x2 * cs) * sc;
                        if (n == 0) { w1.x = cvt_pk_bf16(o1[0], o1[1]); w1.y = cvt_pk_bf16(o1[2], o1[3]); w2.x = cvt_pk_bf16(o2[0], o2[1]); w2.y = cvt_pk_bf16(o2[2], o2[3]); }
                        else        { w1.z = cvt_pk_bf16(o1[0], o1[1]); w1.w = cvt_pk_bf16(o1[2], o1[3]); w2.z = cvt_pk_bf16(o2[0], o2[1]); w2.w = cvt_pk_bf16(o2[2], o2[3]); }
                    }
                    bf16_t* rowp = PROJ + (size_t)t * NPROJ + u.pn * BM + cl;
                    *(u32x4*)rowp = w1; *(u32x4*)(rowp + HALF) = w2;
                }
        } else {
#pragma unroll
            for (int bj = 0; bj < 2; ++bj) {
                const int c0 = u.pn * BM + bj * HALF + cl;
                f32x4 lb0 = (f32x4){0.f, 0.f, 0.f, 0.f}, lb1 = lb0;
                if (cgp == 1) { lb0 = *(const f32x4*)(LB + (c0 - 1024)); lb1 = *(const f32x4*)(LB + (c0 - 1024) + 4); }
#pragma unroll
                for (int ai = 0; ai < 2; ++ai)
#pragma unroll
                    for (int m = 0; m < 4; ++m) {
                        const int t = row0 + ai * HALF + m * 16 + PADM;
                        f32x4 v0 = acc[ai][bj][m][0], v1 = acc[ai][bj][m][1];
                        if (cgp == 0) {
#pragma unroll
                            for (int e = 0; e < 4; ++e) { v0[e] = silu_f(v0[e]) * 0.08838834764831845f; v1[e] = silu_f(v1[e]) * 0.08838834764831845f; }
                        } else if (cgp == 1) {
                            f32x4 l0, l1;
#pragma unroll
                            for (int e = 0; e < 4; ++e) {
                                const float f0 = lb0[e] + (1.0f - lb0[e]) * sigmoid_f(v0[e]), f1 = lb1[e] + (1.0f - lb1[e]) * sigmoid_f(v1[e]);
                                l0[e] = log2f(f0); l1[e] = log2f(f1); v0[e] = 1.0f - f0; v1[e] = 1.0f - f1;
                            }
                            float* lp = LOGF + (size_t)t * 1024 + (c0 - 1024);
                            *(f32x4*)lp = l0; *(f32x4*)(lp + 4) = l1;
                        } else if (cgp == 3 || cgp == 7) {
#pragma unroll
                            for (int e = 0; e < 4; ++e) { v0[e] = silu_f(v0[e]); v1[e] = silu_f(v1[e]); }
                        }
                        u32x4 w; w.x = cvt_pk_bf16(v0[0], v0[1]); w.y = cvt_pk_bf16(v0[2], v0[3]); w.z = cvt_pk_bf16(v1[0], v1[1]); w.w = cvt_pk_bf16(v1[2], v1[3]);
                        *(u32x4*)(PROJ + (size_t)t * NPROJ + c0) = w;
                    }
            }
        }
    }
};

struct EpiResid {
    static constexpr bool PERM = false, AFTER_DRAIN = false;
    const float* src; const float* st; const float* g; const float* b; float* out;
    __device__ __forceinline__ void operator()(const f32x4 (&acc)[2][2][4][2], const Unit& u, int wr, int wc, int fr, int fq) const {
        const int row0 = u.pm * BM + wr * 64 + fr, col0 = u.pn * BM + wc * 32 + 4 * fq;
        f32x4 gv[2][2], bv[2][2];
#pragma unroll
        for (int bj = 0; bj < 2; ++bj)
#pragma unroll
            for (int n = 0; n < 2; ++n) { gv[bj][n] = *(const f32x4*)(g + col0 + bj * HALF + n * 16); bv[bj][n] = *(const f32x4*)(b + col0 + bj * HALF + n * 16); }
#pragma unroll
        for (int ai = 0; ai < 2; ++ai)
#pragma unroll
            for (int m = 0; m < 4; ++m) {
                const int r = row0 + ai * HALF + m * 16; const float mu = st[2 * r], rstd = st[2 * r + 1];
                const size_t off = (size_t)r * DM + col0;
#pragma unroll
                for (int bj = 0; bj < 2; ++bj)
#pragma unroll
                    for (int n = 0; n < 2; ++n) {
                        const f32x4 xv = *(const f32x4*)(src + off + bj * HALF + n * 16);
                        const f32x4 hv = (xv - mu) * rstd * gv[bj][n] + bv[bj][n];
                        *(f32x4*)(out + off + bj * HALF + n * 16) = hv * ALPHA + acc[ai][bj][m][n];
                    }
            }
    }
};

struct EpiGU {
    static constexpr bool PERM = true, AFTER_DRAIN = false;
    bf16_t* ACT;
    __device__ __forceinline__ void operator()(const f32x4 (&acc)[2][2][4][2], const Unit& u, int wr, int wc, int fr, int fq) const {
        const int row0 = u.pm * BM + wr * 64 + fr, c0 = u.pn * HALF + wc * 32 + 8 * fq;
#pragma unroll
        for (int ai = 0; ai < 2; ++ai)
#pragma unroll
            for (int m = 0; m < 4; ++m) {
                const int r = row0 + ai * HALF + m * 16;
                f32x4 v0, v1;
#pragma unroll
                for (int e = 0; e < 4; ++e) { v0[e] = silu_f(acc[ai][0][m][0][e]) * acc[ai][1][m][0][e]; v1[e] = silu_f(acc[ai][0][m][1][e]) * acc[ai][1][m][1][e]; }
                u32x4 w; w.x = cvt_pk_bf16(v0[0], v0[1]); w.y = cvt_pk_bf16(v0[2], v0[3]); w.z = cvt_pk_bf16(v1[0], v1[1]); w.w = cvt_pk_bf16(v1[2], v1[3]);
                *(u32x4*)(ACT + (size_t)r * DFF + c0) = w;
            }
    }
};

template <class Epi, class Sched, bool ALIGN_EPI = false, bool SP2 = false>
__device__ __forceinline__ void gemm_phase(PG8_LAS unsigned char* lds, const Gemm g, const Sched& S, const Epi& E) {
    int tid_ = threadIdx.x; asm volatile("" : "+v"(tid_));
    const int tid = tid_, wid = __builtin_amdgcn_readfirstlane(tid >> 6), lane = tid & 63, wr = wid >> 2, wc = wid & 3, fr = lane & 15, fq = lane >> 4;
    const int K = g.K, nt = K / BK;
    unsigned voffA[2], voffB[2];
#pragma unroll
    for (int i = 0; i < 2; ++i) { int R, C; stage_rc(tid * 16 + i * 8192, R, C); const int Rb = Epi::PERM ? ((R & ~31) + perm32(R & 31)) : R;
        voffA[i] = (unsigned)(R * K + C) * 2u; voffB[i] = (unsigned)(Rb * K + C) * 2u; }
    const size_t kstep = (size_t)(BK * 2);
    const size_t hstep = (size_t)HALF * K * 2;
    const size_t tstep = 2 * hstep;
    const unsigned ldsw = (unsigned)wid * 1024u;
    const int aoff = lds_byte(wr * 64 + fr, fq * 8), boff = lds_byte(wc * 32 + fr, fq * 8);
#define PG8_SA(b, h) (((b) * 2 + (h)) * HTB)
#define PG8_SB(b, h) ((4 + (b) * 2 + (h)) * HTB)
#define PG8_STAGE(bufoff, gbase, voff) do { _Pragma("unroll") for (int _i = 0; _i < 2; ++_i) \
        __builtin_amdgcn_global_load_lds((const unsigned*)((const char*)(gbase) + (voff)[_i]), (PG8_LAS unsigned*)(lds + (bufoff) + ldsw + _i * 8192), 16, 0, 0); } while (0)
#define PG8_LDA(dst, b, h) do { _Pragma("unroll") for (int m = 0; m < 4; ++m) _Pragma("unroll") for (int k = 0; k < 2; ++k) dst[m][k] = *(const PG8_LAS bf16x8*)(lds + PG8_SA(b, h) + aoff + m * 2048 + k * 1024); } while (0)
#define PG8_LDB(dst, b, h) do { _Pragma("unroll") for (int n = 0; n < 2; ++n) _Pragma("unroll") for (int k = 0; k < 2; ++k) dst[n][k] = *(const PG8_LAS bf16x8*)(lds + PG8_SB(b, h) + boff + n * 2048 + k * 1024); } while (0)
#define PG8_MMA(ai, bj, At, Bt) do { __builtin_amdgcn_s_setprio(1); _Pragma("unroll") for (int m = 0; m < 4; ++m) _Pragma("unroll") for (int n = 0; n < 2; ++n) _Pragma("unroll") for (int k = 0; k < 2; ++k) \
        acc[ai][bj][m][n] = __builtin_amdgcn_mfma_f32_16x16x32_bf16(Bt[n][k], At[m][k], acc[ai][bj][m][n], 0, 0, 0); __builtin_amdgcn_s_setprio(0); } while (0)
#define PG8_WAIT_V(n) asm volatile("s_waitcnt vmcnt(" #n ")" ::: "memory")
#define PG8_WAIT_L(n) asm volatile("s_waitcnt lgkmcnt(" #n ")" ::: "memory")
#define PG8_BAR __builtin_amdgcn_s_barrier()
#define PG8_SCHED __builtin_amdgcn_sched_barrier(0)
    Unit cur, nxt; int ui = 0;
    if (!S.next(0, cur)) return;
    f32x4 acc[2][2][4][2];
#pragma unroll
    for (int a = 0; a < 2; ++a)
#pragma unroll
        for (int b = 0; b < 2; ++b)
#pragma unroll
            for (int m = 0; m < 4; ++m)
#pragma unroll
                for (int n = 0; n < 2; ++n) acc[a][b][m][n] = (f32x4){0.f, 0.f, 0.f, 0.f};
    bf16x8 At[4][2], B0[2][2], B1[2][2];
    const char* cA = (const char*)g.A + (size_t)cur.pm * tstep; const char* cB = (const char*)g.Bt + (size_t)cur.pn * tstep;
    S.a_ready(cur);
    if constexpr (SP2) {
        PG8_STAGE(PG8_SB(0, 0), cB, voffB); PG8_STAGE(PG8_SB(0, 1), cB + hstep, voffB); PG8_STAGE(PG8_SA(0, 0), cA, voffA); PG8_STAGE(PG8_SA(0, 1), cA + hstep, voffA);
        if (wr == 1) PG8_BAR;
        PG8_WAIT_V(2); PG8_BAR;
        PG8_STAGE(PG8_SB(1, 0), cB + kstep, voffB); PG8_STAGE(PG8_SA(1, 0), cA + kstep, voffA); PG8_STAGE(PG8_SB(1, 1), cB + hstep + kstep, voffB);
        PG8_WAIT_V(6); PG8_BAR;
    } else {
        PG8_STAGE(PG8_SB(0, 0), cB, voffB); PG8_STAGE(PG8_SA(0, 0), cA, voffA); PG8_STAGE(PG8_SB(0, 1), cB + hstep, voffB); PG8_STAGE(PG8_SA(0, 1), cA + hstep, voffA);
        if (wr == 1) PG8_BAR;
        PG8_WAIT_V(4); PG8_BAR;
        PG8_STAGE(PG8_SB(1, 0), cB + kstep, voffB); PG8_STAGE(PG8_SA(1, 0), cA + kstep, voffA); PG8_STAGE(PG8_SB(1, 1), cB + hstep + kstep, voffB);
        PG8_WAIT_V(6); PG8_BAR;
    }
    for (;;) {
        const bool has_next = S.next(ui + 1, nxt);
        const char* nA = has_next ? (const char*)g.A + (size_t)nxt.pm * tstep : cA; const char* nB = has_next ? (const char*)g.Bt + (size_t)nxt.pn * tstep : cB;
        for (int t = 0; t < nt; t += 2) {
            const bool last = (t == nt - 2);
            const char* a1 = cA + (size_t)(t + 1) * kstep;
            const char* a2 = last ? nA : cA + (size_t)(t + 2) * kstep; const char* b2 = last ? nB : cB + (size_t)(t + 2) * kstep;
            const char* a3 = a2 + kstep; const char* b3 = b2 + kstep;
            if (last && has_next) S.a_ready(nxt);
            if constexpr (SP2) {
            PG8_LDB(B0, 0, 0); PG8_LDB(B1, 0, 1); PG8_SCHED; PG8_LDA(At, 0, 0); PG8_STAGE(PG8_SA(1, 1), a1 + hstep, voffA);
            PG8_WAIT_V(8); PG8_WAIT_L(0); PG8_BAR; PG8_MMA(0, 0, At, B0); PG8_MMA(0, 1, At, B1); PG8_BAR; PG8_SCHED;
            PG8_LDA(At, 0, 1); PG8_STAGE(PG8_SB(0, 0), b2, voffB); PG8_STAGE(PG8_SB(0, 1), b2 + hstep, voffB); PG8_STAGE(PG8_SA(0, 0), a2, voffA);
            PG8_WAIT_V(8); PG8_WAIT_L(0); PG8_BAR; PG8_MMA(1, 0, At, B0); PG8_MMA(1, 1, At, B1); PG8_BAR; PG8_SCHED;
            PG8_LDB(B0, 1, 0); PG8_LDB(B1, 1, 1); PG8_SCHED; PG8_LDA(At, 1, 0); PG8_STAGE(PG8_SA(0, 1), a2 + hstep, voffA);
            PG8_WAIT_V(8); PG8_WAIT_L(0); PG8_BAR; PG8_MMA(0, 0, At, B0); PG8_MMA(0, 1, At, B1); PG8_BAR; PG8_SCHED;
            PG8_LDA(At, 1, 1); PG8_STAGE(PG8_SB(1, 0), b3, voffB); PG8_STAGE(PG8_SB(1, 1), b3 + hstep, voffB); PG8_STAGE(PG8_SA(1, 0), a3, voffA);
            PG8_WAIT_V(8); PG8_WAIT_L(0); PG8_BAR; PG8_MMA(1, 0, At, B0); PG8_MMA(1, 1, At, B1); PG8_BAR; PG8_SCHED;
            } else {
            PG8_LDB(B0, 0, 0); PG8_SCHED; PG8_LDA(At, 0, 0); PG8_STAGE(PG8_SA(1, 1), a1 + hstep, voffA);
            PG8_WAIT_L(8); PG8_BAR; PG8_WAIT_L(0); PG8_MMA(0, 0, At, B0); PG8_BAR; PG8_SCHED;
            PG8_LDB(B1, 0, 1); PG8_STAGE(PG8_SB(0, 0), b2, voffB);
            PG8_BAR; PG8_WAIT_L(0); PG8_MMA(0, 1, At, B1); PG8_BAR;
            PG8_LDA(At, 0, 1); PG8_STAGE(PG8_SA(0, 0), a2, voffA);
            PG8_BAR; PG8_WAIT_L(0); PG8_MMA(1, 0, At, B0); PG8_BAR; PG8_SCHED;
            PG8_STAGE(PG8_SB(0, 1), b2 + hstep, voffB);
            PG8_WAIT_V(6); PG8_BAR; PG8_MMA(1, 1, At, B1); PG8_BAR;
            PG8_LDB(B0, 1, 0); PG8_SCHED; PG8_LDA(At, 1, 0); PG8_STAGE(PG8_SA(0, 1), a2 + hstep, voffA);
            PG8_WAIT_L(8); PG8_BAR; PG8_WAIT_L(0); PG8_MMA(0, 0, At, B0); PG8_BAR; PG8_SCHED;
            PG8_LDB(B1, 1, 1); PG8_STAGE(PG8_SB(1, 0), b3, voffB);
            PG8_BAR; PG8_WAIT_L(0); PG8_MMA(0, 1, At, B1); PG8_BAR;
            PG8_LDA(At, 1, 1); PG8_STAGE(PG8_SA(1, 0), a3, voffA);
            PG8_BAR; PG8_WAIT_L(0); PG8_MMA(1, 0, At, B0); PG8_BAR; PG8_SCHED;
            PG8_STAGE(PG8_SB(1, 1), b3 + hstep, voffB);
            PG8_WAIT_V(6); PG8_BAR; PG8_MMA(1, 1, At, B1); PG8_BAR;
            }
        }
        if constexpr (ALIGN_EPI) { if (wr == 0) PG8_BAR; }
        if constexpr (!Epi::AFTER_DRAIN) { E(acc, cur, wr, wc, fr, fq); S.done(cur); }
        if (!has_next) break;
#pragma unroll
        for (int a = 0; a < 2; ++a)
#pragma unroll
            for (int b = 0; b < 2; ++b)
#pragma unroll
                for (int m = 0; m < 4; ++m)
#pragma unroll
                    for (int n = 0; n < 2; ++n) acc[a][b][m][n] = (f32x4){0.f, 0.f, 0.f, 0.f};
        cur = nxt; cA = nA; cB = nB; ++ui;
        if constexpr (ALIGN_EPI) { if (wr == 1) PG8_BAR; }
    }
    PG8_WAIT_V(0);
    if constexpr (!ALIGN_EPI) { if (wr == 0) PG8_BAR; }
    PG8_BAR;
    if constexpr (Epi::AFTER_DRAIN) { E.fused(acc, cur, wr, wc, fr, fq, lds, wid, lane); S.done(cur); }
#undef PG8_SA
#undef PG8_SB
#undef PG8_STAGE
#undef PG8_LDA
#undef PG8_LDB
#undef PG8_MMA
#undef PG8_WAIT_V
#undef PG8_WAIT_L
#undef PG8_BAR
#undef PG8_SCHED
}
}

constexpr int NWAVES = 8;
constexpr int DM = 2048, SEQ = 8192, LT = 8256, NPROJ = 8192, DFF = 5632, PADM = 64  , PADF = 48, NCHUNK = LT / 64;
constexpr size_t MiB = 1u << 20;
constexpr size_t WS_CTL = 0, CTL_ZERO_BYTES = 64 * 1024;
constexpr size_t WS_LB = 1 * MiB;
constexpr size_t WS_ST0 = 1 * MiB + 64 * 1024;
constexpr size_t WS_ST1 = 1 * MiB + 192 * 1024;
constexpr size_t WS_HM = 1 * MiB + 320 * 1024;
constexpr size_t WS_LG = 1 * MiB + 512 * 1024;
constexpr size_t WS_FH = 34 * MiB, WS_CH = 42 * MiB, WS_FR = 50 * MiB, WS_CR = 58 * MiB;
constexpr size_t WS_WIN = 2 * MiB;
constexpr size_t WS_WOUT = 2 * MiB;
constexpr size_t WS_WDOWN = 10 * MiB;
constexpr size_t WS_H0B = 34 * MiB;
constexpr size_t WS_MIX = 34 * MiB;
constexpr size_t WS_H1B = 34 * MiB;
constexpr size_t WS_PROJ = 66 * MiB;
constexpr size_t WS_Z = 66 * MiB;
constexpr size_t WS_ACT = 130 * MiB;
constexpr size_t WS_LOGF = 195 * MiB;
constexpr size_t WS_WGU = 228 * MiB;
constexpr size_t WS_END = 272 * MiB;
static_assert(WS_PROJ + (size_t)LT * NPROJ * 2 <= WS_LOGF && WS_LOGF + (size_t)LT * 1024 * 4 <= WS_WGU && WS_WGU + (size_t)2 * DFF * DM * 2 <= WS_END, "ws map");
static_assert(WS_ACT + (size_t)SEQ * DFF * 2 <= WS_WGU && WS_Z + (size_t)SEQ * DM * 4 <= WS_ACT && WS_WDOWN + (size_t)DM * DFF * 2 <= WS_H0B, "ws map 2");
constexpr size_t DO_RC = 0, DO_RS = (size_t)LT * 128 * 4;
constexpr int CW_BAR = 1024;
constexpr int RING_OFF = 0, RING_BYTES = 131072, LDSCTL_OFF = RING_BYTES, MISC_OFF = LDSCTL_OFF + 320, LDS_BYTES = 147456;

#define GAS __attribute__((address_space(1)))
#define LAS __attribute__((address_space(3)))
typedef unsigned short bf16;
typedef unsigned v4u __attribute__((ext_vector_type(4)));
typedef unsigned v2u __attribute__((ext_vector_type(2)));
typedef float f32x4 __attribute__((ext_vector_type(4)));
typedef short bf16x8 __attribute__((ext_vector_type(8)));
typedef short bf16x4 __attribute__((ext_vector_type(4)));
typedef GAS unsigned gu32;
#define RLX_AGENT __ATOMIC_RELAXED, __HIP_MEMORY_SCOPE_AGENT
#define LDS_WAIT() asm volatile("s_waitcnt lgkmcnt(0)" ::: "memory")
__device__ __forceinline__ float bf2f(bf16 v) { return __uint_as_float((unsigned)v << 16); }
__device__ __forceinline__ unsigned f2bf(float f) { unsigned u = __builtin_bit_cast(unsigned, f); return (u + 0x7fffu + ((u >> 16) & 1u)) >> 16; }
__device__ __forceinline__ unsigned pk2(float lo, float hi) { return f2bf(lo) | (f2bf(hi) << 16); }
using pg8::fexp; using pg8::silu_f; using pg8::sigmoid_f;

#define XB_TMO      128
#define XB_XCNT(j)  (256  + 64 * (j))
#define XB_XSUB(j)  (1280 + 64 * (j))
#define XB_XGEN(j)  (2304 + 64 * (j))
#define XB_TOP      3328
#define XB_TOPGEN   3392
#define XCD_BAR_WORDS 3456
#define XB_SPIN_CAP (1u << 18)

__device__ __forceinline__ unsigned xb_ld(unsigned* p)              { return __hip_atomic_load(p, __ATOMIC_RELAXED, __HIP_MEMORY_SCOPE_AGENT); }
__device__ __forceinline__ unsigned xb_add(unsigned* p, unsigned v) { return __hip_atomic_fetch_add(p, v, __ATOMIC_RELAXED, __HIP_MEMORY_SCOPE_AGENT); }
__device__ __forceinline__ unsigned xb_xcc_id() { return (unsigned)__builtin_amdgcn_s_getreg((3 << 11) | 20) & 0xFu; }
#define XB_SPIN(cond, bar) do { unsigned _sp = 0; while (cond) { __builtin_amdgcn_s_sleep(1); \
    if ((++_sp & 255u) == 0u) { if (xb_ld(&(bar)[XB_TMO])) break; if (_sp > XB_SPIN_CAP) { atomicAdd(&(bar)[XB_TMO], 1u); break; } } } } while (0)

struct XcdBarrier {
    unsigned* bar; unsigned x;
    volatile LAS unsigned* st;
};

__device__ __forceinline__ XcdBarrier xcd_barrier_post(unsigned* bar, volatile LAS unsigned* st) {
    XcdBarrier b; b.bar = bar; b.x = xb_xcc_id(); b.st = st;
    if (threadIdx.x == 0) (void)xb_add(&bar[XB_XCNT(b.x)], 1u);
    return b;
}
__device__ __forceinline__ void xcd_barrier_complete(unsigned* bar, unsigned x, unsigned& nloc, unsigned& nx) {
    const unsigned G = gridDim.x * gridDim.y * gridDim.z;
    unsigned sum, cnt, mine, sp = 0u;
    for (;;) {
        sum = 0u; cnt = 0u; mine = 0u;
#pragma unroll
        for (unsigned j = 0; j < 16; ++j) { const unsigned c = xb_ld(&bar[XB_XCNT(j)]); sum += c; cnt += (c > 0u) ? 1u : 0u; mine = (j == x) ? c : mine; }
        if (sum == G) break;
        __builtin_amdgcn_s_sleep(1);
        if ((++sp & 255u) == 0u) { if (xb_ld(&bar[XB_TMO])) break; if (sp > XB_SPIN_CAP) { atomicAdd(&bar[XB_TMO], 1u); break; } }
    }
    nloc = mine > 0u ? mine : 1u; nx = cnt > 0u ? cnt : 1u;
}

__device__ __forceinline__ void xcd_barrier(const XcdBarrier& b) {
    asm volatile("s_waitcnt vmcnt(0)" ::: "memory");
    __syncthreads();
    if (threadIdx.x == 0) {
        unsigned* bar = b.bar;
        __builtin_amdgcn_s_waitcnt(0);
        unsigned nloc = b.st[0], nx = b.st[1];
        if (nloc == 0u) { xcd_barrier_complete(bar, b.x, nloc, nx); b.st[0] = nloc; b.st[1] = nx; }
        const unsigned old = xb_add(&bar[XB_XSUB(b.x)], 1u);
        const unsigned gen = old / nloc;
        if (old + 1u == (gen + 1u) * nloc) {
            __builtin_amdgcn_fence(__ATOMIC_RELEASE, "agent");
            asm volatile("s_waitcnt vmcnt(0)" ::: "memory");
            const unsigned og = xb_add(&bar[XB_TOP], 1u);
            const unsigned tg = og / nx;
            if (og + 1u == (tg + 1u) * nx) xb_add(&bar[XB_TOPGEN], 1u);
            else XB_SPIN(xb_ld(&bar[XB_TOPGEN]) == tg, bar);
            __builtin_amdgcn_fence(__ATOMIC_ACQUIRE, "agent");
            xb_add(&bar[XB_XGEN(b.x)], 1u);
            asm volatile("s_waitcnt vmcnt(0)" ::: "memory");
        } else {
            XB_SPIN(xb_ld(&bar[XB_XGEN(b.x)]) == gen, bar);
            __builtin_amdgcn_fence(__ATOMIC_ACQUIRE, "agent");
            asm volatile("s_waitcnt vmcnt(0)" ::: "memory");
        }
    }
    __syncthreads();
}

struct Frame {
    LAS unsigned char* lds;
    volatile LAS unsigned* MISC;
    int tid, lane, wave, G;
    const float *x, *meta, *ln_in_g, *ln_in_b, *hlb, *w_in, *hg_ng, *ret_ng, *ret_nb, *w_out, *ln1_g, *ln1_b, *w_gate, *w_up, *w_down, *ln2_g, *ln2_b;
    float* out; unsigned char* ws;
};
__device__ __forceinline__ float wave_sum(float v) {
#pragma unroll
    for (int o = 1; o < 64; o <<= 1) v += __shfl_xor(v, o);
    return v;
}
template <int MAP> __device__ __forceinline__ void transpose_item(const float* W, int K, int N, bf16* WT, LAS float* scr, int item, int lane) {
    const int nblk = N / 32, kb = item / nblk, nb = item % nblk, k0 = 64 * kb, n0 = 32 * nb;
    const int rbase = (MAP == 0) ? n0 : (256 * (n0 >> 7) + (n0 & 127) + (MAP == 2 ? 128 : 0));
#pragma unroll 8
    for (int i = 0; i < 32; ++i) { const int kk = 2 * i + (lane >> 5); scr[kk * 33 + (lane & 31)] = W[(size_t)(k0 + kk) * N + n0 + (lane & 31)]; }
    LDS_WAIT(); asm volatile("" ::: "memory");
    const int c = lane & 7;
#pragma unroll
    for (int j = 0; j < 4; ++j) { const int n = (lane >> 3) + 8 * j; const LAS float* s = scr + (8 * c) * 33 + n;
        v4u o; o.x = pk2(s[0 * 33], s[1 * 33]); o.y = pk2(s[2 * 33], s[3 * 33]); o.z = pk2(s[4 * 33], s[5 * 33]); o.w = pk2(s[6 * 33], s[7 * 33]);
        *(GAS v4u*)(WT + (size_t)(rbase + n) * K + k0 + 8 * c) = o; }
    LDS_WAIT(); asm volatile("" ::: "memory");
}
__device__ __forceinline__ void ln_row(const float* xrow, bool zero_in, const float* g, const float* b, bf16* ob, float* of, float* st, int lane) {
    const GAS f32x4* xr = (const GAS f32x4*)xrow + lane;
    f32x4 v[8]; float s = 0.f;
#pragma unroll
    for (int j = 0; j < 8; ++j) { v[j] = zero_in ? (f32x4){0.f, 0.f, 0.f, 0.f} : xr[64 * j]; s += (v[j].x + v[j].y) + (v[j].z + v[j].w); }
    const float mean = wave_sum(s) * (1.f / DM); float s2 = 0.f;
#pragma unroll
    for (int j = 0; j < 8; ++j) { v[j] = v[j] - mean; s2 += (v[j].x * v[j].x + v[j].y * v[j].y) + (v[j].z * v[j].z + v[j].w * v[j].w); }
    const float rstd = 1.f / sqrtf(wave_sum(s2) * (1.f / DM) + 1e-5f);
#pragma unroll
    for (int j = 0; j < 8; ++j) {
        const f32x4 gv = *((const GAS f32x4*)g + lane + 64 * j), bv = *((const GAS f32x4*)b + lane + 64 * j);
        const f32x4 y = v[j] * rstd * gv + bv;
        if (ob) *((GAS v2u*)ob + lane + 64 * j) = (v2u){pk2(y.x, y.y), pk2(y.z, y.w)};
        if (of) *((GAS f32x4*)of + lane + 64 * j) = y;
    }
    if (st && lane == 0) { st[0] = mean; st[1] = rstd; }
}

#define TR4(d0, d1, d2, d3, base, o0, o1, o2, o3) asm volatile( \
    "ds_read_b64_tr_b16 %0, %4 offset:%5\n\tds_read_b64_tr_b16 %1, %4 offset:%6\n\tds_read_b64_tr_b16 %2, %4 offset:%7\n\tds_read_b64_tr_b16 %3, %4 offset:%8\n\ts_waitcnt lgkmcnt(0)" \
    : "=&v"(d0), "=&v"(d1), "=&v"(d2), "=&v"(d3) : "v"(base), "i"(o0), "i"(o1), "i"(o2), "i"(o3) : "memory")
#define TR8(d0, d1, d2, d3, d4, d5, d6, d7, base, o0, o1, o2, o3, o4, o5, o6, o7) asm volatile( \
    "ds_read_b64_tr_b16 %0, %8 offset:%9\n\tds_read_b64_tr_b16 %1, %8 offset:%10\n\tds_read_b64_tr_b16 %2, %8 offset:%11\n\tds_read_b64_tr_b16 %3, %8 offset:%12\n\t" \
    "ds_read_b64_tr_b16 %4, %8 offset:%13\n\tds_read_b64_tr_b16 %5, %8 offset:%14\n\tds_read_b64_tr_b16 %6, %8 offset:%15\n\tds_read_b64_tr_b16 %7, %8 offset:%16\n\ts_waitcnt lgkmcnt(0)" \
    : "=&v"(d0), "=&v"(d1), "=&v"(d2), "=&v"(d3), "=&v"(d4), "=&v"(d5), "=&v"(d6), "=&v"(d7) \
    : "v"(base), "i"(o0), "i"(o1), "i"(o2), "i"(o3), "i"(o4), "i"(o5), "i"(o6), "i"(o7) : "memory")
__device__ __forceinline__ bf16x8 cat4(bf16x4 lo, bf16x4 hi) { bf16x8 r; r[0] = lo[0]; r[1] = lo[1]; r[2] = lo[2]; r[3] = lo[3]; r[4] = hi[0]; r[5] = hi[1]; r[6] = hi[2]; r[7] = hi[3]; return r; }
#define MFMA16(a, b, c) __builtin_amdgcn_mfma_f32_16x16x32_bf16((a), (b), (c), 0, 0, 0)
#define LBAR() do { asm volatile("s_waitcnt lgkmcnt(0)" ::: "memory"); __builtin_amdgcn_s_barrier(); asm volatile("" ::: "memory"); } while (0)
using pg8::cvt_pk_bf16;
__device__ __forceinline__ float ex2(float x) { return __builtin_amdgcn_exp2f(x); }
__device__ __forceinline__ bf16x8 pack8(const f32x4& a, const f32x4& b) {
    union { unsigned u[4]; bf16x8 v; } r; r.u[0] = cvt_pk_bf16(a[0], a[1]); r.u[1] = cvt_pk_bf16(a[2], a[3]); r.u[2] = cvt_pk_bf16(b[0], b[1]); r.u[3] = cvt_pk_bf16(b[2], b[3]); return r.v; }

constexpr int HG_G = 16, RT_G = 8;
__host__ __device__ __forceinline__ int hg_cb(int g) { return g == 0 ? 0 : 8 * g + 1; }
__host__ __device__ __forceinline__ int rt_cb(int g) { return g == 0 ? 0 : 16 * g + 1; }

constexpr int HQS = 272;
constexpr int H_QD = 0, H_KD = H_QD + 64 * HQS, H_V = H_KD + 64 * HQS, H_SB = H_V + 64 * HQS, H_EL = H_SB + 128 * HQS, H_TOT = H_EL + 512, H_END = H_TOT + 16 * 128 * 4;
static_assert(H_END <= RING_BYTES, "hgrn lds");
struct HRegs { f32x4 lf[4]; v2u qn[4], kn[4]; v4u vn[2]; };
struct HCtx { LAS unsigned char* lds; const bf16* PROJ; const float* LOGF; float* HGO; int h, tid, lane, w, r16, q4, tq, vg, a_, p_, cg, rg; unsigned lbase; };
template <int MODE> __device__ __forceinline__ void h_load(HRegs& R, const HCtx& X, int c) {
    const int t0 = c * 64;
#pragma unroll
    for (int i = 0; i < 4; ++i) { const size_t row = (size_t)(t0 + 4 * X.rg + i);
        R.lf[i] = *(const f32x4*)(X.LOGF + row * 1024 + X.h * 128 + 4 * X.cg);
        if (MODE == 1) R.qn[i] = *(const v2u*)(X.PROJ + row * NPROJ + X.h * 128 + 4 * X.cg);
        R.kn[i] = *(const v2u*)(X.PROJ + row * NPROJ + 1024 + X.h * 128 + 4 * X.cg); }
#pragma unroll
    for (int i = 0; i < 2; ++i) { const int id = X.tid + 512 * i; R.vn[i] = *(const v4u*)(X.PROJ + (size_t)(t0 + (id >> 4)) * NPROJ + 2048 + X.h * 128 + (id & 15) * 8); }
}
template <int MODE> __device__ __forceinline__ void h_step(HRegs& R, const HCtx& X, f32x4 (&S)[2][4], f32x4& lgsum, int c, bool do_load, int c_load) {
    LAS unsigned char* lds = X.lds; const int cg = X.cg, rg = X.rg, r16 = X.r16, q4 = X.q4, tq = X.tq, vg = X.vg;
    const int t0 = c * 64;
    f32x4 cs[4]; f32x4 run = (f32x4){0.f, 0.f, 0.f, 0.f};
#pragma unroll
    for (int i = 0; i < 4; ++i) { run = run + R.lf[i]; cs[i] = run; }
    *(LAS f32x4*)(lds + H_TOT + (rg * 128 + 4 * cg) * 4) = run;
    LBAR();
    f32x4 off = (f32x4){0.f, 0.f, 0.f, 0.f};
    for (int r2 = 0; r2 < 2 * X.w; ++r2) off = off + *(const LAS f32x4*)(lds + H_TOT + (r2 * 128 + 4 * cg) * 4);
    if (rg & 1) off = off + *(const LAS f32x4*)(lds + H_TOT + ((rg - 1) * 128 + 4 * cg) * 4);
#pragma unroll
    for (int i = 0; i < 4; ++i) {
        const f32x4 cum = off + cs[i];
        const v2u kn = R.kn[i];
        const float k0 = __uint_as_float(kn.x << 16), k1 = __uint_as_float(kn.x & 0xffff0000u), k2 = __uint_as_float(kn.y << 16), k3 = __uint_as_float(kn.y & 0xffff0000u);
        *(LAS v2u*)(lds + H_KD + (4 * rg + i) * HQS + 8 * cg) = (v2u){cvt_pk_bf16(k0 * ex2(-cum[0]), k1 * ex2(-cum[1])), cvt_pk_bf16(k2 * ex2(-cum[2]), k3 * ex2(-cum[3]))};
        if (MODE == 1) {
            const v2u qn = R.qn[i];
            const float q0 = __uint_as_float(qn.x << 16), q1 = __uint_as_float(qn.x & 0xffff0000u), q2 = __uint_as_float(qn.y << 16), q3 = __uint_as_float(qn.y & 0xffff0000u);
            *(LAS v2u*)(lds + H_QD + (4 * rg + i) * HQS + 8 * cg) = (v2u){cvt_pk_bf16(q0 * ex2(cum[0]), q1 * ex2(cum[1])), cvt_pk_bf16(q2 * ex2(cum[2]), q3 * ex2(cum[3]))};
        }
    }
    if (rg == 15) { const f32x4 last = off + run; lgsum = lgsum + last; *(LAS f32x4*)(lds + H_EL + 16 * cg) = (f32x4){ex2(last[0]), ex2(last[1]), ex2(last[2]), ex2(last[3])}; }
#pragma unroll
    for (int i = 0; i < 2; ++i) { const int id = X.tid + 512 * i; *(LAS v4u*)(lds + H_V + (id >> 4) * HQS + (id & 15) * 16) = R.vn[i]; }
    if (MODE == 1) {
#pragma unroll
        for (int u = 0; u < 2; ++u)
#pragma unroll
            for (int vt = 0; vt < 4; ++vt)
                *(LAS v2u*)(lds + H_SB + (16 * (4 * vg + vt) + r16) * HQS + (16 * (2 * tq + u) + 4 * q4) * 2) = (v2u){cvt_pk_bf16(S[u][vt][0], S[u][vt][1]), cvt_pk_bf16(S[u][vt][2], S[u][vt][3])};
    }
    LBAR();
    if (do_load) h_load<MODE>(R, X, c_load);
    if (MODE == 1) {
        bf16x8 qf[4];
#pragma unroll
        for (int kb = 0; kb < 4; ++kb) qf[kb] = *(const LAS bf16x8*)(lds + H_QD + (16 * tq + r16) * HQS + (32 * kb + 8 * q4) * 2);
        f32x4 o[4];
#pragma unroll
        for (int vt = 0; vt < 4; ++vt) {
            o[vt] = (f32x4){0.f, 0.f, 0.f, 0.f};
#pragma unroll
            for (int kb = 0; kb < 4; ++kb) o[vt] = MFMA16(qf[kb], *(const LAS bf16x8*)(lds + H_SB + (16 * (4 * vg + vt) + r16) * HQS + (32 * kb + 8 * q4) * 2), o[vt]);
        }
#pragma unroll
        for (int p = 0; p < 2; ++p) {
            if (2 * p <= tq) {
                f32x4 xa = (f32x4){0.f, 0.f, 0.f, 0.f}, xb = xa;
#pragma unroll
                for (int kb = 0; kb < 4; ++kb) xa = MFMA16(*(const LAS bf16x8*)(lds + H_KD + (32 * p + r16) * HQS + (32 * kb + 8 * q4) * 2), qf[kb], xa);
                if (2 * p == tq) {
#pragma unroll
                    for (int i = 0; i < 4; ++i) if (4 * q4 + i > r16) xa[i] = 0.f;
                }
                if (2 * p + 1 <= tq) {
#pragma unroll
                    for (int kb = 0; kb < 4; ++kb) xb = MFMA16(*(const LAS bf16x8*)(lds + H_KD + (32 * p + 16 + r16) * HQS + (32 * kb + 8 * q4) * 2), qf[kb], xb);
                    if (2 * p + 1 == tq) {
#pragma unroll
                        for (int i = 0; i < 4; ++i) if (4 * q4 + i > r16) xb[i] = 0.f;
                    }
                }
                const bf16x8 pa = pack8(xa, xb);
                bf16x4 e0, e1, e2, e3, e4, e5, e6, e7;
                const unsigned va = X.lbase + H_V + (32 * p + 4 * q4 + X.a_) * HQS + (64 * vg + 4 * X.p_) * 2;
                TR8(e0, e1, e2, e3, e4, e5, e6, e7, va, 0, 16 * HQS, 32, 16 * HQS + 32, 64, 16 * HQS + 64, 96, 16 * HQS + 96);
                o[0] = MFMA16(pa, cat4(e0, e1), o[0]); o[1] = MFMA16(pa, cat4(e2, e3), o[1]); o[2] = MFMA16(pa, cat4(e4, e5), o[2]); o[3] = MFMA16(pa, cat4(e6, e7), o[3]);
            }
        }
        if (c > 0) {
#pragma unroll
            for (int vt = 0; vt < 4; ++vt)
#pragma unroll
                for (int i = 0; i < 4; ++i) X.HGO[(size_t)(t0 - PADM + 16 * tq + 4 * q4 + i) * 1024 + X.h * 128 + 16 * (4 * vg + vt) + r16] = o[vt][i];
        }
    }
    {
        bf16x4 a0, a1, a2, a3, a4, a5, a6, a7;
        const unsigned ka = X.lbase + H_KD + (8 * q4 + X.a_) * HQS + (32 * tq + 4 * X.p_) * 2;
        TR8(a0, a1, a2, a3, a4, a5, a6, a7, ka, 0, 4 * HQS, 32 * HQS, 36 * HQS, 32, 4 * HQS + 32, 32 * HQS + 32, 36 * HQS + 32);
        const bf16x8 A00 = cat4(a0, a1), A01 = cat4(a2, a3), A10 = cat4(a4, a5), A11 = cat4(a6, a7);
        const unsigned va = X.lbase + H_V + (8 * q4 + X.a_) * HQS + (64 * vg + 4 * X.p_) * 2;
#pragma unroll
        for (int vp = 0; vp < 2; ++vp) {
            bf16x4 b0, b1, b2, b3, b4, b5, b6, b7;
            if (vp == 0) TR8(b0, b1, b2, b3, b4, b5, b6, b7, va, 0, 4 * HQS, 32 * HQS, 36 * HQS, 32, 4 * HQS + 32, 32 * HQS + 32, 36 * HQS + 32);
            else         TR8(b0, b1, b2, b3, b4, b5, b6, b7, va, 64, 4 * HQS + 64, 32 * HQS + 64, 36 * HQS + 64, 96, 4 * HQS + 96, 32 * HQS + 96, 36 * HQS + 96);
            const bf16x8 B00 = cat4(b0, b1), B01 = cat4(b2, b3), B10 = cat4(b4, b5), B11 = cat4(b6, b7);
            S[0][2 * vp] = MFMA16(A00, B00, S[0][2 * vp]); S[0][2 * vp] = MFMA16(A01, B01, S[0][2 * vp]);
            S[0][2 * vp + 1] = MFMA16(A00, B10, S[0][2 * vp + 1]); S[0][2 * vp + 1] = MFMA16(A01, B11, S[0][2 * vp + 1]);
            S[1][2 * vp] = MFMA16(A10, B00, S[1][2 * vp]); S[1][2 * vp] = MFMA16(A11, B01, S[1][2 * vp]);
            S[1][2 * vp + 1] = MFMA16(A10, B10, S[1][2 * vp + 1]); S[1][2 * vp + 1] = MFMA16(A11, B11, S[1][2 * vp + 1]);
        }
#pragma unroll
        for (int u = 0; u < 2; ++u) { const f32x4 el = *(const LAS f32x4*)(lds + H_EL + (16 * (2 * tq + u) + 4 * q4) * 4);
#pragma unroll
            for (int vt = 0; vt < 4; ++vt) S[u][vt] = S[u][vt] * el; }
    }
}
template <int MODE> __device__ __forceinline__ void hgrn_scan(LAS unsigned char* lds, const bf16* __restrict__ PROJ, const float* __restrict__ LOGF, float* __restrict__ HGO,
                                                              const float* __restrict__ Cin, float* __restrict__ Fout, float* __restrict__ LG, int g, int h) {
    int tid_ = threadIdx.x; asm volatile("" : "+v"(tid_));
    HCtx X; X.lds = lds; X.PROJ = PROJ; X.LOGF = LOGF; X.HGO = HGO; X.h = h;
    X.tid = tid_; X.lane = tid_ & 63; X.w = __builtin_amdgcn_readfirstlane(tid_ >> 6);
    X.r16 = X.lane & 15; X.q4 = X.lane >> 4; X.tq = X.w >> 1; X.vg = X.w & 1;
    X.a_ = (X.lane & 15) >> 2; X.p_ = X.lane & 3; X.cg = tid_ & 31; X.rg = tid_ >> 5;
    X.lbase = (unsigned)(size_t)lds;
    const int cb = hg_cb(g), ce = hg_cb(g + 1);
    f32x4 S[2][4]; f32x4 lgsum = (f32x4){0.f, 0.f, 0.f, 0.f};
#pragma unroll
    for (int u = 0; u < 2; ++u)
#pragma unroll
        for (int vt = 0; vt < 4; ++vt) {
            S[u][vt] = (f32x4){0.f, 0.f, 0.f, 0.f};
            if (MODE == 1 && g > 0) {
#pragma unroll
                for (int i = 0; i < 4; ++i) S[u][vt][i] = Cin[((size_t)(g * 8 + h) * 128 + 16 * (2 * X.tq + u) + 4 * X.q4 + i) * 128 + 16 * (4 * X.vg + vt) + X.r16];
            }
        }
    HRegs A, B;
    h_load<MODE>(A, X, cb);
    if (cb + 1 < ce) h_load<MODE>(B, X, cb + 1);
    for (int c = cb; c < ce; c += 2) {
        h_step<MODE>(A, X, S, lgsum, c, c + 2 < ce, c + 2);
        if (c + 1 < ce) h_step<MODE>(B, X, S, lgsum, c + 1, c + 3 < ce, c + 3);
    }
    if (MODE == 0) {
#pragma unroll
        for (int u = 0; u < 2; ++u)
#pragma unroll
            for (int vt = 0; vt < 4; ++vt)
#pragma unroll
                for (int i = 0; i < 4; ++i) Fout[((size_t)(g * 8 + h) * 128 + 16 * (2 * X.tq + u) + 4 * X.q4 + i) * 128 + 16 * (4 * X.vg + vt) + X.r16] = S[u][vt][i];
        if (X.rg == 15) *(f32x4*)(LG + (size_t)(g * 8 + h) * 128 + 4 * X.cg) = lgsum;
    }
    LBAR();
}

constexpr int RQS = 528, RVS = 144;
constexpr int R_Q = 0, R_K = R_Q + 64 * RQS, R_VD = R_K + 64 * RQS, R_RB = R_VD + 64 * RVS, R_END = R_RB + 64 * RQS;
static_assert(R_END <= RING_BYTES, "ret lds");
struct RRegs { v4u qn[4], kn[4]; v4u vn; };
struct RCtx { LAS unsigned char* lds; const bf16* PROJ; float* RETO; int h, j, tid, lane, w, r16, q4, tq, vg, a_, p_; unsigned lbase; float l2g, g64; };
template <int MODE> __device__ __forceinline__ void r_load(RRegs& R, const RCtx& X, int c) {
    const int t0 = c * 64;
#pragma unroll
    for (int i = 0; i < 4; ++i) { const int id = X.tid + 512 * i, row = id >> 5, ch = id & 31;
        if (MODE == 1) R.qn[i] = *(const v4u*)(X.PROJ + (size_t)(t0 + row) * NPROJ + 4096 + X.h * 256 + ch * 8);
        R.kn[i] = *(const v4u*)(X.PROJ + (size_t)(t0 + row) * NPROJ + 5120 + X.h * 256 + ch * 8); }
    R.vn = *(const v4u*)(X.PROJ + (size_t)(t0 + (X.tid >> 3)) * NPROJ + 6144 + X.h * 256 + 64 * X.j + (X.tid & 7) * 8);
}
template <int MODE> __device__ __forceinline__ void r_step(RRegs& Rg, const RCtx& X, f32x4 (&R)[4][2], int c, bool do_load, int c_load) {
    LAS unsigned char* lds = X.lds; const int r16 = X.r16, q4 = X.q4, tq = X.tq, vg = X.vg; const float l2g = X.l2g;
    const int t0 = c * 64;
    LBAR();
#pragma unroll
    for (int i = 0; i < 4; ++i) { const int id = X.tid + 512 * i, row = id >> 5, ch = id & 31;
        if (MODE == 1) *(LAS v4u*)(lds + R_Q + row * RQS + ch * 16) = Rg.qn[i];
        *(LAS v4u*)(lds + R_K + row * RQS + ch * 16) = Rg.kn[i]; }
    { const int vs = X.tid >> 3, vq = X.tid & 7; const v4u vn = Rg.vn;
      const float dec = ex2((float)(63 - vs) * l2g); v4u wv;
#pragma unroll
      for (int e = 0; e < 4; ++e) wv[e] = cvt_pk_bf16(__uint_as_float(vn[e] << 16) * dec, __uint_as_float(vn[e] & 0xffff0000u) * dec);
      *(LAS v4u*)(lds + R_VD + vs * RVS + vq * 16) = wv; }
    if (MODE == 1) {
#pragma unroll
        for (int u = 0; u < 4; ++u)
#pragma unroll
            for (int vt = 0; vt < 2; ++vt)
                *(LAS v2u*)(lds + R_RB + (16 * (2 * vg + vt) + r16) * RQS + (16 * (4 * tq + u) + 4 * q4) * 2) = (v2u){cvt_pk_bf16(R[u][vt][0], R[u][vt][1]), cvt_pk_bf16(R[u][vt][2], R[u][vt][3])};
    }
    LBAR();
    if (do_load) r_load<MODE>(Rg, X, c_load);
    if (MODE == 1) {
        bf16x8 qf[8];
#pragma unroll
        for (int kb = 0; kb < 8; ++kb) qf[kb] = *(const LAS bf16x8*)(lds + R_Q + (16 * tq + r16) * RQS + (32 * kb + 8 * q4) * 2);
        f32x4 o3[2], o2[2];
#pragma unroll
        for (int vt = 0; vt < 2; ++vt) {
            o3[vt] = (f32x4){0.f, 0.f, 0.f, 0.f}; o2[vt] = o3[vt];
#pragma unroll
            for (int kb = 0; kb < 8; ++kb) o3[vt] = MFMA16(qf[kb], *(const LAS bf16x8*)(lds + R_RB + (16 * (2 * vg + vt) + r16) * RQS + (32 * kb + 8 * q4) * 2), o3[vt]);
        }
#pragma unroll
        for (int p = 0; p < 2; ++p) {
            if (2 * p <= tq) {
                f32x4 xa = (f32x4){0.f, 0.f, 0.f, 0.f}, xb = xa;
#pragma unroll
                for (int kb = 0; kb < 8; ++kb) xa = MFMA16(*(const LAS bf16x8*)(lds + R_K + (32 * p + r16) * RQS + (32 * kb + 8 * q4) * 2), qf[kb], xa);
                if (2 * p == tq) {
#pragma unroll
                    for (int i = 0; i < 4; ++i) if (4 * q4 + i > r16) xa[i] = 0.f;
                }
                if (2 * p + 1 <= tq) {
#pragma unroll
                    for (int kb = 0; kb < 8; ++kb) xb = MFMA16(*(const LAS bf16x8*)(lds + R_K + (32 * p + 16 + r16) * RQS + (32 * kb + 8 * q4) * 2), qf[kb], xb);
                    if (2 * p + 1 == tq) {
#pragma unroll
                        for (int i = 0; i < 4; ++i) if (4 * q4 + i > r16) xb[i] = 0.f;
                    }
                }
                const bf16x8 pa = pack8(xa, xb);
                bf16x4 e0, e1, e2, e3;
                const unsigned va = X.lbase + R_VD + (32 * p + 4 * q4 + X.a_) * RVS + (32 * vg + 4 * X.p_) * 2;
                TR4(e0, e1, e2, e3, va, 0, 16 * RVS, 32, 16 * RVS + 32);
                o2[0] = MFMA16(pa, cat4(e0, e1), o2[0]); o2[1] = MFMA16(pa, cat4(e2, e3), o2[1]);
            }
        }
        if (c > 0) {
#pragma unroll
            for (int i = 0; i < 4; ++i) {
                const int tl = 16 * tq + 4 * q4 + i; const float f3 = ex2((float)(tl + 1) * l2g), f2 = ex2((float)(tl - 63) * l2g);
#pragma unroll
                for (int vt = 0; vt < 2; ++vt) X.RETO[(size_t)(t0 - PADM + tl) * 1024 + X.h * 256 + 64 * X.j + 16 * (2 * vg + vt) + r16] = f3 * o3[vt][i] + f2 * o2[vt][i];
            }
        }
    }
    {
        bf16x4 b0, b1, b2, b3, b4, b5, b6, b7;
        const unsigned va = X.lbase + R_VD + (8 * q4 + X.a_) * RVS + (32 * vg + 4 * X.p_) * 2;
        TR8(b0, b1, b2, b3, b4, b5, b6, b7, va, 0, 4 * RVS, 32 * RVS, 36 * RVS, 32, 4 * RVS + 32, 32 * RVS + 32, 36 * RVS + 32);
        const bf16x8 B00 = cat4(b0, b1), B01 = cat4(b2, b3), B10 = cat4(b4, b5), B11 = cat4(b6, b7);
        const unsigned ka = X.lbase + R_K + (8 * q4 + X.a_) * RQS + (64 * tq + 4 * X.p_) * 2;
#pragma unroll
        for (int up = 0; up < 2; ++up) {
            bf16x4 a0, a1, a2, a3, a4, a5, a6, a7;
            if (up == 0) TR8(a0, a1, a2, a3, a4, a5, a6, a7, ka, 0, 4 * RQS, 32 * RQS, 36 * RQS, 32, 4 * RQS + 32, 32 * RQS + 32, 36 * RQS + 32);
            else         TR8(a0, a1, a2, a3, a4, a5, a6, a7, ka, 64, 4 * RQS + 64, 32 * RQS + 64, 36 * RQS + 64, 96, 4 * RQS + 96, 32 * RQS + 96, 36 * RQS + 96);
            const bf16x8 A00 = cat4(a0, a1), A01 = cat4(a2, a3), A10 = cat4(a4, a5), A11 = cat4(a6, a7);
#pragma unroll
            for (int vt = 0; vt < 2; ++vt) { R[2 * up][vt] = R[2 * up][vt] * X.g64; R[2 * up + 1][vt] = R[2 * up + 1][vt] * X.g64; }
            R[2 * up][0] = MFMA16(A00, B00, R[2 * up][0]); R[2 * up][0] = MFMA16(A01, B01, R[2 * up][0]);
            R[2 * up][1] = MFMA16(A00, B10, R[2 * up][1]); R[2 * up][1] = MFMA16(A01, B11, R[2 * up][1]);
            R[2 * up + 1][0] = MFMA16(A10, B00, R[2 * up + 1][0]); R[2 * up + 1][0] = MFMA16(A11, B01, R[2 * up + 1][0]);
            R[2 * up + 1][1] = MFMA16(A10, B10, R[2 * up + 1][1]); R[2 * up + 1][1] = MFMA16(A11, B11, R[2 * up + 1][1]);
        }
    }
}
template <int MODE> __device__ __forceinline__ void ret_scan(LAS unsigned char* lds, const bf16* __restrict__ PROJ, float* __restrict__ RETO,
                                                             const float* __restrict__ Cin, float* __restrict__ Fout, int g, int h, int j) {
    int tid_ = threadIdx.x; asm volatile("" : "+v"(tid_));
    RCtx X; X.lds = lds; X.PROJ = PROJ; X.RETO = RETO; X.h = h; X.j = j;
    X.tid = tid_; X.lane = tid_ & 63; X.w = __builtin_amdgcn_readfirstlane(tid_ >> 6);
    X.r16 = X.lane & 15; X.q4 = X.lane >> 4; X.tq = X.w >> 1; X.vg = X.w & 1;
    X.a_ = (X.lane & 15) >> 2; X.p_ = X.lane & 3;
    X.lbase = (unsigned)(size_t)lds;
    X.l2g = log2f(1.0f - exp2f(-5.0f - (float)h)); X.g64 = ex2(64.0f * X.l2g);
    const int cb = rt_cb(g), ce = rt_cb(g + 1);
    f32x4 R[4][2];
#pragma unroll
    for (int u = 0; u < 4; ++u)
#pragma unroll
        for (int vt = 0; vt < 2; ++vt) {
            R[u][vt] = (f32x4){0.f, 0.f, 0.f, 0.f};
            if (MODE == 1 && g > 0) {
#pragma unroll
                for (int i = 0; i < 4; ++i) R[u][vt][i] = Cin[((size_t)(g * 4 + h) * 256 + 16 * (4 * X.tq + u) + 4 * X.q4 + i) * 256 + 64 * j + 16 * (2 * X.vg + vt) + X.r16];
            }
        }
    RRegs A, B;
    r_load<MODE>(A, X, cb);
    if (cb + 1 < ce) r_load<MODE>(B, X, cb + 1);
    for (int c = cb; c < ce; c += 2) {
        r_step<MODE>(A, X, R, c, c + 2 < ce, c + 2);
        if (c + 1 < ce) r_step<MODE>(B, X, R, c + 1, c + 3 < ce, c + 3);
    }
    if (MODE == 0) {
#pragma unroll
        for (int u = 0; u < 4; ++u)
#pragma unroll
            for (int vt = 0; vt < 2; ++vt)
#pragma unroll
                for (int i = 0; i < 4; ++i) Fout[((size_t)(g * 4 + h) * 256 + 16 * (4 * X.tq + u) + 4 * X.q4 + i) * 256 + 64 * j + 16 * (2 * X.vg + vt) + X.r16] = R[u][vt][i];
    }
    LBAR();
}

__device__ __forceinline__ void meta_proj(Frame& F, const bf16* __restrict__ WINT, const bf16* __restrict__ HM, bf16* PROJ, float* LOGF, const float* LB, const float* RC, const float* RS) {
    LAS unsigned char* hm = F.lds;
    for (int i = F.tid; i < 16 * 2048 * 2 / 16; i += 512) *(LAS v4u*)(hm + 16 * i) = *((const v4u*)HM + i);
    __syncthreads();
    const int r = F.tid >> 5, ci = F.tid & 31, t = PADF + r;
    for (int grp = blockIdx.x; grp < 256; grp += F.G) {
        int col; int mode;
        if (grp < 128) { col = 32 * grp + ci; mode = col >> 10; }
        else if (grp < 192) { const int g2 = grp - 128, region = g2 >> 3, jj = g2 & 7; col = 4096 + region * 256 + 16 * jj + (ci & 15) + 128 * (ci >> 4); mode = 4 + (region >> 2); }
        else { col = 6144 + 32 * (grp - 192) + ci; mode = col >> 10; }
        const v4u* wrow = (const v4u*)(WINT + (size_t)col * DM);
        float acc = 0.f;
#pragma unroll 4
        for (int k8 = 0; k8 < 256; ++k8) {
            const v4u wv = wrow[k8]; const v4u hv = *(const LAS v4u*)(hm + r * 4096 + 16 * k8);
#pragma unroll
            for (int e = 0; e < 4; ++e) {
                acc = fmaf(__uint_as_float(wv[e] << 16), __uint_as_float(hv[e] << 16), acc);
                acc = fmaf(__uint_as_float(wv[e] & 0xffff0000u), __uint_as_float(hv[e] & 0xffff0000u), acc);
            }
        }
        const float partner = __shfl_xor(acc, 16);
        float o = acc;
        if (mode == 0) o = silu_f(acc) * 0.08838834764831845f;
        else if (mode == 1) { const float lb = LB[col - 1024]; const float f = lb + (1.0f - lb) * sigmoid_f(acc); LOGF[(size_t)t * 1024 + col - 1024] = log2f(f); o = 1.0f - f; }
        else if (mode == 3 || mode == 7) o = silu_f(acc);
        else if (mode == 4 || mode == 5) {
            const int hi = ci >> 4, d = (col - 4096) & 127;
            const float cs = RC[(size_t)t * 128 + d], sn = RS[(size_t)t * 128 + d];
            const float x1 = hi ? partner : acc, x2 = hi ? acc : partner;
            o = hi ? (x1 * sn + x2 * cs) : (x1 * cs - x2 * sn);
            if (mode == 5) o *= 0.0625f;
        }
        PROJ[(size_t)t * NPROJ + col] = (bf16)f2bf(o);
    }
    __syncthreads();
}

struct Args { const float* in[17]; float* out; unsigned char* ws; };
__global__ void __launch_bounds__(NWAVES * 64, 2) mega_fwd(Args args) {
    extern __shared__ __attribute__((aligned(16))) unsigned char lds_raw[];
    Frame F;
    F.lds = (LAS unsigned char*)lds_raw;
    F.MISC = (volatile LAS unsigned*)(F.lds + MISC_OFF);
#define REFRESH() do { int t_ = threadIdx.x; asm volatile("" : "+v"(t_)); F.tid = t_; F.lane = t_ & 63; } while (0)
    REFRESH(); F.wave = __builtin_amdgcn_readfirstlane(F.tid >> 6); F.G = gridDim.x;
    F.x = args.in[0]; F.meta = args.in[1]; F.ln_in_g = args.in[2]; F.ln_in_b = args.in[3]; F.hlb = args.in[4]; F.w_in = args.in[5]; F.hg_ng = args.in[6]; F.ret_ng = args.in[7];
    F.ret_nb = args.in[8]; F.w_out = args.in[9]; F.ln1_g = args.in[10]; F.ln1_b = args.in[11]; F.w_gate = args.in[12]; F.w_up = args.in[13]; F.w_down = args.in[14];
    F.ln2_g = args.in[15]; F.ln2_b = args.in[16]; F.out = args.out; F.ws = args.ws;
    unsigned char* ws = args.ws;
    float* LB = (float*)(ws + WS_LB); float* ST0 = (float*)(ws + WS_ST0); float* ST1 = (float*)(ws + WS_ST1); bf16* HM = (bf16*)(ws + WS_HM);
    bf16* WINT = (bf16*)(ws + WS_WIN); bf16* WOUTT = (bf16*)(ws + WS_WOUT); bf16* WDOWNT = (bf16*)(ws + WS_WDOWN); bf16* WGUT = (bf16*)(ws + WS_WGU);
    bf16* H0B = (bf16*)(ws + WS_H0B); bf16* MIX = (bf16*)(ws + WS_MIX); bf16* H1B = (bf16*)(ws + WS_H1B); bf16* PROJ = (bf16*)(ws + WS_PROJ);
    float* Z = (float*)(ws + WS_Z); bf16* ACT = (bf16*)(ws + WS_ACT); float* LOGF = (float*)(ws + WS_LOGF);
    float* RC = (float*)((unsigned char*)args.out + DO_RC); float* RS = (float*)((unsigned char*)args.out + DO_RS);
    float* HGO = args.out; float* RETO = args.out + (size_t)SEQ * 1024;
    for (int u = F.tid; u < (LDS_BYTES - LDSCTL_OFF) / 4; u += NWAVES * 64) ((LAS unsigned*)(F.lds + LDSCTL_OFF))[u] = 0u;
    __syncthreads();
    XcdBarrier bar = xcd_barrier_post((unsigned*)(ws + WS_CTL) + CW_BAR, F.MISC + 8);
    const int gw = blockIdx.x * NWAVES + F.wave, NGW = F.G * NWAVES;
#ifdef PROBE_A
    int n_stamp = 0;
#define STAMP() do { if (blockIdx.x == 0 && F.tid == 0) ((unsigned long long*)(ws + WS_CTL + 32768))[n_stamp] = __builtin_amdgcn_s_memrealtime(); ++n_stamp; } while (0)
#else
#define STAMP() do {} while (0)
#endif
    STAMP();

    {
        LAS float* scr = (LAS float*)(F.lds + RING_OFF + F.wave * 16384);
        constexpr int I_IN = (DM / 64) * (NPROJ / 32);
        for (int it = gw; it < I_IN; it += NGW) transpose_item<0>(F.w_in, DM, NPROJ, WINT, scr, it, F.lane);
        for (int m = gw; m < SEQ; m += NGW) ln_row(F.x + (size_t)m * DM, false, F.ln_in_g, F.ln_in_b, H0B + (size_t)m * DM, nullptr, ST0 + 2 * m, F.lane);
        if (gw < 16) ln_row(F.meta + (size_t)gw * DM, false, F.ln_in_g, F.ln_in_b, HM + (size_t)gw * DM, nullptr, nullptr, F.lane);
        for (int t = gw; t < LT; t += NGW) {
#pragma unroll
            for (int hh = 0; hh < 2; ++hh) {
                const int d = F.lane + 64 * hh;
                const float invf = (float)pow(10000.0, -(double)d / 128.0);
                const float ang = (float)(t - PADF) * invf;
                RC[(size_t)t * 128 + d] = (float)cos((double)ang); RS[(size_t)t * 128 + d] = (float)sin((double)ang);
            }
        }
        if (gw < 16) { const int jx = gw * 64 + F.lane; LB[jx] = 1.0f / (1.0f + expf(F.hlb[1024 + jx] - F.hlb[jx])); }
        for (int i = blockIdx.x * 512 + F.tid; i < PADF * NPROJ * 2 / 16; i += F.G * 512) *((GAS v4u*)PROJ + i) = (v4u){0u, 0u, 0u, 0u};
        for (int i = blockIdx.x * 512 + F.tid; i < PADF * 1024 * 4 / 16; i += F.G * 512) *((GAS v4u*)LOGF + i) = (v4u){0u, 0u, 0u, 0u};
    }
    xcd_barrier(bar); STAMP(); REFRESH();

    {
        meta_proj(F, WINT, HM, PROJ, LOGF, LB, RC, RS);
        pg8::Gemm g{H0B, WINT, SEQ, NPROJ, DM}; pg8::StaticOrder S; S.init(SEQ, NPROJ, F.G, (int)blockIdx.x);
        pg8::EpiProj E{PROJ, LOGF, LB, RC, RS};
        pg8::gemm_phase<pg8::EpiProj, pg8::StaticOrder, true, true>(F.lds + RING_OFF, g, S, E);
    }
    xcd_barrier(bar); STAMP(); REFRESH();

    float* FH = (float*)(ws + WS_FH); float* CH = (float*)(ws + WS_CH); float* FR = (float*)(ws + WS_FR); float* CR = (float*)(ws + WS_CR); float* LG = (float*)(ws + WS_LG);
    {
        for (int it = blockIdx.x; it < 256; it += F.G) {
            if (it < 128) { const int g = it >> 3, h = it & 7; if (g < HG_G - 1) hgrn_scan<0>(F.lds, PROJ, LOGF, HGO, nullptr, FH, LG, g, h); }
            else { const int i2 = it - 128, g = i2 >> 4, h = (i2 >> 2) & 3, j = i2 & 3; if (g < RT_G - 1) ret_scan<0>(F.lds, PROJ, RETO, nullptr, FR, g, h, j); }
        }
        LAS float* scr = (LAS float*)(F.lds + RING_OFF + F.wave * 16384);
        constexpr int I_O = (DM / 64) * (DM / 32), I_D = (DFF / 64) * (DM / 32), I_G = (DM / 64) * (DFF / 32);
        for (int it = gw; it < I_O + I_D + 2 * I_G; it += NGW) {
            int r = it;
            if (r < I_O) { transpose_item<0>(F.w_out, DM, DM, WOUTT, scr, r, F.lane); continue; } r -= I_O;
            if (r < I_D) { transpose_item<0>(F.w_down, DFF, DM, WDOWNT, scr, r, F.lane); continue; } r -= I_D;
            if (r < I_G) { transpose_item<1>(F.w_gate, DM, DFF, WGUT, scr, r, F.lane); continue; } r -= I_G;
            transpose_item<2>(F.w_up, DM, DFF, WGUT, scr, r, F.lane);
        }
    }
    xcd_barrier(bar); STAMP(); REFRESH();
    {
        const int gt = blockIdx.x * 512 + F.tid, NT = F.G * 512;
        for (int e = gt; e < 8 * 128 * 128; e += NT) {
            const int hk = e >> 7;
            float cv = 0.f;
            for (int g = 0; g < HG_G - 1; ++g) { cv = ex2(LG[(size_t)g * 1024 + hk]) * cv + FH[(size_t)g * 131072 + e]; CH[(size_t)(g + 1) * 131072 + e] = cv; }
        }
        for (int e = gt; e < 4 * 256 * 256; e += NT) {
            const int h = e >> 16; const float l2g = log2f(1.0f - exp2f(-5.0f - (float)h));
            float cv = 0.f;
            for (int g = 0; g < RT_G - 1; ++g) { cv = ex2(64.0f * (float)(rt_cb(g + 1) - rt_cb(g)) * l2g) * cv + FR[(size_t)g * 262144 + e]; CR[(size_t)(g + 1) * 262144 + e] = cv; }
        }
    }
    xcd_barrier(bar); STAMP(); REFRESH();
    for (int it = blockIdx.x; it < 256; it += F.G) {
        if (it < 128) { const int g = it >> 3, h = it & 7; hgrn_scan<1>(F.lds, PROJ, LOGF, HGO, CH, nullptr, nullptr, g, h); }
        else { const int i2 = it - 128, g = i2 >> 4, h = (i2 >> 2) & 3, j = i2 & 3; ret_scan<1>(F.lds, PROJ, RETO, CR, nullptr, g, h, j); }
    }
    xcd_barrier(bar); STAMP(); REFRESH();

    for (int r = gw; r < SEQ; r += NGW) {
        const int t = r + PADM, c0 = 16 * F.lane;
        {
            f32x4 o[4]; float s = 0.f;
#pragma unroll
            for (int i = 0; i < 4; ++i) { o[i] = *(const GAS f32x4*)(HGO + (size_t)r * 1024 + c0 + 4 * i); s += (o[i].x * o[i].x + o[i].y * o[i].y) + (o[i].z * o[i].z + o[i].w * o[i].w); }
            s += __shfl_xor(s, 1); s += __shfl_xor(s, 2); s += __shfl_xor(s, 4);
            const float rs = 1.0f / sqrtf(s * (1.f / 128.f) + 1e-6f);
            const v4u g0 = *(const GAS v4u*)(PROJ + (size_t)t * NPROJ + 3072 + c0), g1 = *(const GAS v4u*)(PROJ + (size_t)t * NPROJ + 3072 + c0 + 8);
            unsigned wout[8];
#pragma unroll
            for (int i = 0; i < 4; ++i) {
                const f32x4 ng = *(const GAS f32x4*)(F.hg_ng + c0 + 4 * i);
                const unsigned ga = (i < 2) ? g0[2 * i] : g1[2 * (i - 2)], gb = (i < 2) ? g0[2 * i + 1] : g1[2 * (i - 2) + 1];
                const float y0 = o[i].x * rs * ng.x * __uint_as_float(ga << 16), y1 = o[i].y * rs * ng.y * __uint_as_float(ga & 0xffff0000u);
                const float y2 = o[i].z * rs * ng.z * __uint_as_float(gb << 16), y3 = o[i].w * rs * ng.w * __uint_as_float(gb & 0xffff0000u);
                wout[2 * i] = pk2(y0, y1); wout[2 * i + 1] = pk2(y2, y3);
            }
            *(GAS v4u*)(MIX + (size_t)r * DM + c0) = (v4u){wout[0], wout[1], wout[2], wout[3]};
            *(GAS v4u*)(MIX + (size_t)r * DM + c0 + 8) = (v4u){wout[4], wout[5], wout[6], wout[7]};
        }
        {
            f32x4 o[4]; float s = 0.f;
#pragma unroll
            for (int i = 0; i < 4; ++i) { o[i] = *(const GAS f32x4*)(RETO + (size_t)r * 1024 + c0 + 4 * i); s += (o[i].x + o[i].y) + (o[i].z + o[i].w); }
            s += __shfl_xor(s, 1); s += __shfl_xor(s, 2); s += __shfl_xor(s, 4); s += __shfl_xor(s, 8);
            const float mu = s * (1.f / 256.f); float q = 0.f;
#pragma unroll
            for (int i = 0; i < 4; ++i) { o[i] = o[i] - mu; q += (o[i].x * o[i].x + o[i].y * o[i].y) + (o[i].z * o[i].z + o[i].w * o[i].w); }
            q += __shfl_xor(q, 1); q += __shfl_xor(q, 2); q += __shfl_xor(q, 4); q += __shfl_xor(q, 8);
            const float rs = 1.0f / sqrtf(q * (1.f / 256.f) + 1e-6f);
            const v4u g0 = *(const GAS v4u*)(PROJ + (size_t)t * NPROJ + 7168 + c0), g1 = *(const GAS v4u*)(PROJ + (size_t)t * NPROJ + 7168 + c0 + 8);
            unsigned wout[8];
#pragma unroll
            for (int i = 0; i < 4; ++i) {
                const f32x4 ng = *(const GAS f32x4*)(F.ret_ng + c0 + 4 * i), nb = *(const GAS f32x4*)(F.ret_nb + c0 + 4 * i);
                const unsigned ga = (i < 2) ? g0[2 * i] : g1[2 * (i - 2)], gb = (i < 2) ? g0[2 * i + 1] : g1[2 * (i - 2) + 1];
                const float y0 = (o[i].x * rs * ng.x + nb.x) * __uint_as_float(ga << 16), y1 = (o[i].y * rs * ng.y + nb.y) * __uint_as_float(ga & 0xffff0000u);
                const float y2 = (o[i].z * rs * ng.z + nb.z) * __uint_as_float(gb << 16), y3 = (o[i].w * rs * ng.w + nb.w) * __uint_as_float(gb & 0xffff0000u);
                wout[2 * i] = pk2(y0, y1); wout[2 * i + 1] = pk2(y2, y3);
            }
            *(GAS v4u*)(MIX + (size_t)r * DM + 1024 + c0) = (v4u){wout[0], wout[1], wout[2], wout[3]};
            *(GAS v4u*)(MIX + (size_t)r * DM + 1024 + c0 + 8) = (v4u){wout[4], wout[5], wout[6], wout[7]};
        }
    }
    xcd_barrier(bar); STAMP(); REFRESH();

    {
        pg8::Gemm g{MIX, WOUTT, SEQ, DM, DM}; pg8::StaticOrder S; S.init(SEQ, DM, F.G, (int)blockIdx.x);
        pg8::EpiResid E{F.x, ST0, F.ln_in_g, F.ln_in_b, Z};
        pg8::gemm_phase<pg8::EpiResid, pg8::StaticOrder, true, true>(F.lds + RING_OFF, g, S, E);
    }
    xcd_barrier(bar); STAMP(); REFRESH();
    for (int m = gw; m < SEQ; m += NGW) ln_row(Z + (size_t)m * DM, false, F.ln1_g, F.ln1_b, H1B + (size_t)m * DM, nullptr, ST1 + 2 * m, F.lane);
    xcd_barrier(bar); STAMP(); REFRESH();
    {
        pg8::Gemm g{H1B, WGUT, SEQ, 2 * DFF, DM}; pg8::StaticOrder S; S.init(SEQ, 2 * DFF, F.G, (int)blockIdx.x);
        pg8::EpiGU E{ACT};
        pg8::gemm_phase<pg8::EpiGU, pg8::StaticOrder, true, true>(F.lds + RING_OFF, g, S, E);
    }
    xcd_barrier(bar); STAMP(); REFRESH();
    {
        pg8::Gemm g{ACT, WDOWNT, SEQ, DM, DFF}; pg8::StaticOrder S; S.init(SEQ, DM, F.G, (int)blockIdx.x);
        pg8::EpiResid E{Z, ST1, F.ln1_g, F.ln1_b, F.out};
        pg8::gemm_phase<pg8::EpiResid, pg8::StaticOrder, true, true>(F.lds + RING_OFF, g, S, E);
    }
    xcd_barrier(bar); STAMP(); REFRESH();
    for (int m = gw; m < SEQ; m += NGW) ln_row(F.out + (size_t)m * DM, false, F.ln2_g, F.ln2_b, nullptr, F.out + (size_t)m * DM, nullptr, F.lane);
#ifdef PROBE_A
    xcd_barrier(bar); STAMP(); REFRESH();
    {
        const unsigned long long* ts = (const unsigned long long*)(ws + WS_CTL + 32768);
        const unsigned long long ta0 = __hip_atomic_load(ts + PROBE_A, RLX_AGENT), ta1 = __hip_atomic_load(ts + PROBE_A + 1, RLX_AGENT);
        const unsigned long long tb0 = __hip_atomic_load(ts + PROBE_B, RLX_AGENT), tb1 = __hip_atomic_load(ts + PROBE_B + 1, RLX_AGENT);
        const float a_us = (float)(ta1 - ta0) * 0.01f, b_us = (float)(tb1 - tb0) * 0.01f;
        if (blockIdx.x == 0 && F.tid == 0) F.out[0] += a_us * 0.1f;
        for (int i = blockIdx.x * 512 + F.tid; i < 512 * DM; i += F.G * 512) F.out[(size_t)4096 * DM + i] += b_us * 0.001f;
    }
#endif
}

extern "C" void kernel_launch(void* const* d_in, const int* in_sizes, int n_in, void* d_out, int out_size, void* d_ws, size_t ws_size, hipStream_t stream) {
    static int grid = 0;
    if (grid == 0) {
        if (n_in != 17 || out_size != SEQ * DM || ws_size < WS_END) { fprintf(stderr, "kernel_launch: unexpected shapes (n_in %d out %d ws %zu)\n", n_in, out_size, ws_size); grid = -1; return; }
        int dev = 0, cus = 0, per_cu = 0;
        if (hipGetDevice(&dev) != hipSuccess || hipDeviceGetAttribute(&cus, hipDeviceAttributeMultiprocessorCount, dev) != hipSuccess) { grid = -1; return; }
        if (hipFuncSetAttribute((const void*)mega_fwd, hipFuncAttributeMaxDynamicSharedMemorySize, LDS_BYTES) != hipSuccess) { fprintf(stderr, "kernel_launch: hipFuncSetAttribute failed\n"); grid = -1; return; }
        if (hipOccupancyMaxActiveBlocksPerMultiprocessor(&per_cu, (const void*)mega_fwd, NWAVES * 64, LDS_BYTES) != hipSuccess || per_cu < 1) { fprintf(stderr, "kernel_launch: occupancy query says %d\n", per_cu); (void)hipGetLastError(); per_cu = 1; }
        grid = cus * 1;
    }
    if (grid < 0) return;
    (void)hipMemsetAsync((char*)d_ws + WS_CTL, 0, CTL_ZERO_BYTES, stream);
    Args a{};
    for (int i = 0; i < 17; ++i) a.in[i] = (const float*)d_in[i];
    a.out = (float*)d_out; a.ws = (unsigned char*)d_ws;
    void* kargs[] = {&a};
    hipError_t e = hipLaunchCooperativeKernel((const void*)mega_fwd, dim3(grid), dim3(NWAVES * 64), kargs, LDS_BYTES, stream);
    if (e != hipSuccess) fprintf(stderr, "kernel_launch: cooperative launch failed: %s (grid %d)\n", hipGetErrorString(e), grid);
}
```

```cpp
#include <hip/hip_runtime.h>
#include <cstdio>
#include <cstdint>
#include <math.h>

namespace pg8 {
#define PG8_LAS __attribute__((address_space(3)))
typedef unsigned short bf16_t;
typedef short bf16x8 __attribute__((ext_vector_type(8)));
typedef float f32x4 __attribute__((ext_vector_type(4)));
typedef unsigned u32x4 __attribute__((ext_vector_type(4)));
constexpr int BM = 256, BK = 64, HALF = 128, HTB = HALF * BK * 2  , STAGE_BYTES = 8 * HTB, NXCD = 8, WGM = 8;

__host__ __device__ __forceinline__ int lds_byte(int r, int c) { const int st = (r >> 4) * 2 + (c >> 5), rr = r & 15, cc = c & 31, ob = rr * 64 + cc * 2; return st * 1024 + (ob ^ (((ob >> 9) & 1) << 5)); }
__host__ __device__ __forceinline__ void stage_rc(int b, int& R, int& C) { const int st = b / 1024, sb = b % 1024, swz = sb ^ (((sb >> 9) & 1) << 5); R = (st >> 1) * 16 + swz / 64; C = (st & 1) * 32 + (swz % 64) / 2; }
__host__ __device__ __forceinline__ int perm32(int rho) { const int n = rho >> 4, i = rho & 15; return 8 * (i >> 2) + 4 * n + (i & 3); }

struct Unit { int pm, pn; };
struct Gemm { const bf16_t* A; const bf16_t* Bt; int M, N, K; };

struct StaticOrder {
    int nM, nN, nwg, G, c;
    __host__ __device__ void init(int M, int N, int G_, int c_) { nM = M / BM; nN = N / BM; nwg = nM * nN; G = G_; c = c_; }
    __host__ __device__ bool next(int i, Unit& u) const {
        const long L = (long)i * G + c; if (L >= nwg) return false;
        int wgid = (int)L; { const int q = nwg / NXCD, r = nwg % NXCD, xcd = wgid % NXCD, off = wgid / NXCD; wgid = (xcd < r ? xcd * (q + 1) : r * (q + 1) + (xcd - r) * q) + off; }
        const int nig = WGM * nN, gid = wgid / nig, fm = gid * WGM, gsz = (nM - fm) < WGM ? (nM - fm) : WGM;
        u.pm = fm + ((wgid % nig) % gsz); u.pn = (wgid % nig) / gsz; return true;
    }
    __device__ __forceinline__ void a_ready(const Unit&) const {}
    __device__ __forceinline__ void done(const Unit&) const {}
};

__device__ __forceinline__ unsigned cvt_pk_bf16(float lo, float hi) { unsigned r; asm volatile("v_cvt_pk_bf16_f32 %0, %1, %2" : "=v"(r) : "v"(lo), "v"(hi)); return r; }
__device__ __forceinline__ float fexp(float x) { return __builtin_amdgcn_exp2f(x * 1.4426950408889634f); }
__device__ __forceinline__ float silu_f(float x) { return x * __builtin_amdgcn_rcpf(1.0f + fexp(-x)); }
__device__ __forceinline__ float sigmoid_f(float x) { return __builtin_amdgcn_rcpf(1.0f + fexp(-x)); }

constexpr int NPROJ = 8192, DM = 2048, DFF = 5632, PADM = 64;
constexpr float ALPHA = 1.18920711500272f;


struct EpiProj {
    static constexpr bool PERM = true, AFTER_DRAIN = false;
    bf16_t* PROJ; float* LOGF; const float* LB; const float* RC; const float* RS;
    __device__ __forceinline__ void operator()(const f32x4 (&acc)[2][2][4][2], const Unit& u, int wr, int wc, int fr, int fq) const {
        const int cgp = u.pn >> 2, row0 = u.pm * BM + wr * 64 + fr, cl = wc * 32 + 8 * fq;
        if (cgp == 4 || cgp == 5) {
            const float sc = (cgp == 5) ? 0.0625f : 1.0f;
#pragma unroll
            for (int ai = 0; ai < 2; ++ai)
#pragma unroll
                for (int m = 0; m < 4; ++m) {
                    const int t = row0 + ai * HALF + m * 16 + PADM;
                    u32x4 w1, w2;
#pragma unroll
                    for (int n = 0; n < 2; ++n) {
                        const f32x4 cs = *(const f32x4*)(RC + (size_t)t * 128 + cl + 4 * n), sn = *(const f32x4*)(RS + (size_t)t * 128 + cl + 4 * n);
                        const f32x4 x1 = acc[ai][0][m][n], x2 = acc[ai][1][m][n];
                        const f32x4 o1 = (x1 * cs - x2 * sn) * sc, o2 = (x1 * sn + x2 * cs) * sc;
                        if (n == 0) { w1.x = cvt_pk_bf16(o1[0], o1[1]); w1.y = cvt_pk_bf16(o1[2], o1[3]); w2.x = cvt_pk_bf16(o2[0], o2[1]); w2.y = cvt_pk_bf16(o2[2], o2[3]); }
                        else        { w1.z = cvt_pk_bf16(o1[0], o1[1]); w1.w = cvt_pk_bf16(o1[2], o1[3]); w2.z = cvt_pk_bf16(o2[0], o2[1]); w2.w = cvt_pk_bf16(o2[2], o2[3]); }
                    }
                    bf16_t* rowp = PROJ + (size_t)t * NPROJ + u.pn * BM + cl;
                    *(u32x4*)rowp = w1; *(u32x4*)(rowp + HALF) = w2;
                }
        } else {
#pragma unroll
            for (int bj = 0; bj < 2; ++bj) {
                const int c0 = u.pn * BM + bj * HALF + cl;
                f32x4 lb0 = (f32x4){0.f, 0.f, 0.f, 0.f}, lb1 = lb0;
                if (cgp == 1) { lb0 = *(const f32x4*)(LB + (c0 - 1024)); lb1 = *(const f32x4*)(LB + (c0 - 1024) + 4); }
#pragma unroll
                for (int ai = 0; ai < 2; ++ai)
#pragma unroll
                    for (int m = 0; m < 4; ++m) {
                        const int t = row0 + ai * HALF + m * 16 + PADM;
                        f32x4 v0 = acc[ai][bj][m][0], v1 = acc[ai][bj][m][1];
                        if (cgp == 0) {
#pragma unroll
                            for (int e = 0; e < 4; ++e) { v0[e] = silu_f(v0[e]) * 0.08838834764831845f; v1[e] = silu_f(v1[e]) * 0.08838834764831845f; }
                        } else if (cgp == 1) {
                            f32x4 l0, l1;
#pragma unroll
                            for (int e = 0; e < 4; ++e) {
                                const float f0 = lb0[e] + (1.0f - lb0[e]) * sigmoid_f(v0[e]), f1 = lb1[e] + (1.0f - lb1[e]) * sigmoid_f(v1[e]);
                                l0[e] = log2f(f0); l1[e] = log2f(f1); v0[e] = 1.0f - f0; v1[e] = 1.0f - f1;
                            }
                            float* lp = LOGF + (size_t)t * 1024 + (c0 - 1024);
                            *(f32x4*)lp = l0; *(f32x4*)(lp + 4) = l1;
                        } else if (cgp == 3 || cgp == 7) {
#pragma unroll
                            for (int e = 0; e < 4; ++e) { v0[e] = silu_f(v0[e]); v1[e] = silu_f(v1[e]); }
                        }
                        u32x4 w; w.x = cvt_pk_bf16(v0[0], v0[1]); w.y = cvt_pk_bf16(v0[2], v0[3]); w.z = cvt_pk_bf16(v1[0], v1[1]); w.w = cvt_pk_bf16(v1[2], v1[3]);
                        *(u32x4*)(PROJ + (size_t)t * NPROJ + c0) = w;
                    }
            }
        }
    }
};

struct EpiResid {
    static constexpr bool PERM = false, AFTER_DRAIN = false;
    const float* src; const float* st; const float* g; const float* b; float* out;
    __device__ __forceinline__ void operator()(const f32x4 (&acc)[2][2][4][2], const Unit& u, int wr, int wc, int fr, int fq) const {
        const int row0 = u.pm * BM + wr * 64 + fr, col0 = u.pn * BM + wc * 32 + 4 * fq;
        f32x4 gv[2][2], bv[2][2];
#pragma unroll
        for (int bj = 0; bj < 2; ++bj)
#pragma unroll
            for (int n = 0; n < 2; ++n) { gv[bj][n] = *(const f32x4*)(g + col0 + bj * HALF + n * 16); bv[bj][n] = *(const f32x4*)(b + col0 + bj * HALF + n * 16); }
#pragma unroll
        for (int ai = 0; ai < 2; ++ai)
#pragma unroll
            for (int m = 0; m < 4; ++m) {
                const int r = row0 + ai * HALF + m * 16; const float mu = st[2 * r], rstd = st[2 * r + 1];
                const size_t off = (size_t)r * DM + col0;
#pragma unroll
                for (int bj = 0; bj < 2; ++bj)
#pragma unroll
                    for (int n = 0; n < 2; ++n) {
                        const f32x4 xv = *(const f32x4*)(src + off + bj * HALF + n * 16);
                        const f32x4 hv = (xv - mu) * rstd * gv[bj][n] + bv[bj][n];
                        *(f32x4*)(out + off + bj * HALF + n * 16) = hv * ALPHA + acc[ai][bj][m][n];
                    }
            }
    }
};

struct EpiGU {
    static constexpr bool PERM = true, AFTER_DRAIN = false;
    bf16_t* ACT;
    __device__ __forceinline__ void operator()(const f32x4 (&acc)[2][2][4][2], const Unit& u, int wr, int wc, int fr, int fq) const {
        const int row0 = u.pm * BM + wr * 64 + fr, c0 = u.pn * HALF + wc * 32 + 8 * fq;
#pragma unroll
        for (int ai = 0; ai < 2; ++ai)
#pragma unroll
            for (int m = 0; m < 4; ++m) {
                const int r = row0 + ai * HALF + m * 16;
                f32x4 v0, v1;
#pragma unroll
                for (int e = 0; e < 4; ++e) { v0[e] = silu_f(acc[ai][0][m][0][e]) * acc[ai][1][m][0][e]; v1[e] = silu_f(acc[ai][0][m][1][e]) * acc[ai][1][m][1][e]; }
                u32x4 w; w.x = cvt_pk_bf16(v0[0], v0[1]); w.y = cvt_pk_bf16(v0[2], v0[3]); w.z = cvt_pk_bf16(v1[0], v1[1]); w.w = cvt_pk_bf16(v1[2], v1[3]);
                *(u32x4*)(ACT + (size_t)r * DFF + c0) = w;
            }
    }
};

template <class Epi, class Sched, bool ALIGN_EPI = false, bool SP2 = false>
__device__ __forceinline__ void gemm_phase(PG8_LAS unsigned char* lds, const Gemm g, const Sched& S, const Epi& E) {
    int tid_ = threadIdx.x; asm volatile("" : "+v"(tid_));
    const int tid = tid_, wid = __builtin_amdgcn_readfirstlane(tid >> 6), lane = tid & 63, wr = wid >> 2, wc = wid & 3, fr = lane & 15, fq = lane >> 4;
    const int K = g.K, nt = K / BK;
    unsigned voffA[2], voffB[2];
#pragma unroll
    for (int i = 0; i < 2; ++i) { int R, C; stage_rc(tid * 16 + i * 8192, R, C); const int Rb = Epi::PERM ? ((R & ~31) + perm32(R & 31)) : R;
        voffA[i] = (unsigned)(R * K + C) * 2u; voffB[i] = (unsigned)(Rb * K + C) * 2u; }
    const size_t kstep = (size_t)(BK * 2);
    const size_t hstep = (size_t)HALF * K * 2;
    const size_t tstep = 2 * hstep;
    const unsigned ldsw = (unsigned)wid * 1024u;
    const int aoff = lds_byte(wr * 64 + fr, fq * 8), boff = lds_byte(wc * 32 + fr, fq * 8);
#define PG8_SA(b, h) (((b) * 2 + (h)) * HTB)
#define PG8_SB(b, h) ((4 + (b) * 2 + (h)) * HTB)
#define PG8_STAGE(bufoff, gbase, voff) do { _Pragma("unroll") for (int _i = 0; _i < 2; ++_i) \
        __builtin_amdgcn_global_load_lds((const unsigned*)((const char*)(gbase) + (voff)[_i]), (PG8_LAS unsigned*)(lds + (bufoff) + ldsw + _i * 8192), 16, 0, 0); } while (0)
#define PG8_LDA(dst, b, h) do { _Pragma("unroll") for (int m = 0; m < 4; ++m) _Pragma("unroll") for (int k = 0; k < 2; ++k) dst[m][k] = *(const PG8_LAS bf16x8*)(lds + PG8_SA(b, h) + aoff + m * 2048 + k * 1024); } while (0)
#define PG8_LDB(dst, b, h) do { _Pragma("unroll") for (int n = 0; n < 2; ++n) _Pragma("unroll") for (int k = 0; k < 2; ++k) dst[n][k] = *(const PG8_LAS bf16x8*)(lds + PG8_SB(b, h) + boff + n * 2048 + k * 1024); } while (0)
#define PG8_MMA(ai, bj, At, Bt) do { __builtin_amdgcn_s_setprio(1); _Pragma("unroll") for (int m = 0; m < 4; ++m) _Pragma("unroll") for (int n = 0; n < 2; ++n) _Pragma("unroll") for (int k = 0; k < 2; ++k) \
        acc[ai][bj][m][n] = __builtin_amdgcn_mfma_f32_16x16x32_bf16(Bt[n][k], At[m][k], acc[ai][bj][m][n], 0, 0, 0); __builtin_amdgcn_s_setprio(0); } while (0)
#define PG8_WAIT_V(n) asm volatile("s_waitcnt vmcnt(" #n ")" ::: "memory")
#define PG8_WAIT_L(n) asm volatile("s_waitcnt lgkmcnt(" #n ")" ::: "memory")
#define PG8_BAR __builtin_amdgcn_s_barrier()
#define PG8_SCHED __builtin_amdgcn_sched_barrier(0)
    Unit cur, nxt; int ui = 0;
    if (!S.next(0, cur)) return;
    f32x4 acc[2][2][4][2];
#pragma unroll
    for (int a = 0; a < 2; ++a)
#pragma unroll
        for (int b = 0; b < 2; ++b)
#pragma unroll
            for (int m = 0; m < 4; ++m)
#pragma unroll
                for (int n = 0; n < 2; ++n) acc[a][b][m][n] = (f32x4){0.f, 0.f, 0.f, 0.f};
    bf16x8 At[4][2], B0[2][2], B1[2][2];
    const char* cA = (const char*)g.A + (size_t)cur.pm * tstep; const char* cB = (const char*)g.Bt + (size_t)cur.pn * tstep;
    S.a_ready(cur);
    if constexpr (SP2) {
        PG8_STAGE(PG8_SB(0, 0), cB, voffB); PG8_STAGE(PG8_SB(0, 1), cB + hstep, voffB); PG8_STAGE(PG8_SA(0, 0), cA, voffA); PG8_STAGE(PG8_SA(0, 1), cA + hstep, voffA);
        if (wr == 1) PG8_BAR;
        PG8_WAIT_V(2); PG8_BAR;
        PG8_STAGE(PG8_SB(1, 0), cB + kstep, voffB); PG8_STAGE(PG8_SA(1, 0), cA + kstep, voffA); PG8_STAGE(PG8_SB(1, 1), cB + hstep + kstep, voffB);
        PG8_WAIT_V(6); PG8_BAR;
    } else {
        PG8_STAGE(PG8_SB(0, 0), cB, voffB); PG8_STAGE(PG8_SA(0, 0), cA, voffA); PG8_STAGE(PG8_SB(0, 1), cB + hstep, voffB); PG8_STAGE(PG8_SA(0, 1), cA + hstep, voffA);
        if (wr == 1) PG8_BAR;
        PG8_WAIT_V(4); PG8_BAR;
        PG8_STAGE(PG8_SB(1, 0), cB + kstep, voffB); PG8_STAGE(PG8_SA(1, 0), cA + kstep, voffA); PG8_STAGE(PG8_SB(1, 1), cB + hstep + kstep, voffB);
        PG8_WAIT_V(6); PG8_BAR;
    }
    for (;;) {
        const bool has_next = S.next(ui + 1, nxt);
        const char* nA = has_next ? (const char*)g.A + (size_t)nxt.pm * tstep : cA; const char* nB = has_next ? (const char*)g.Bt + (size_t)nxt.pn * tstep : cB;
        for (int t = 0; t < nt; t += 2) {
            const bool last = (t == nt - 2);
            const char* a1 = cA + (size_t)(t + 1) * kstep;
            const char* a2 = last ? nA : cA + (size_t)(t + 2) * kstep; const char* b2 = last ? nB : cB + (size_t)(t + 2) * kstep;
            const char* a3 = a2 + kstep; const char* b3 = b2 + kstep;
            if (last && has_next) S.a_ready(nxt);
            if constexpr (SP2) {
            PG8_LDB(B0, 0, 0); PG8_LDB(B1, 0, 1); PG8_SCHED; PG8_LDA(At, 0, 0); PG8_STAGE(PG8_SA(1, 1), a1 + hstep, voffA);
            PG8_WAIT_V(8); PG8_WAIT_L(0); PG8_BAR; PG8_MMA(0, 0, At, B0); PG8_MMA(0, 1, At, B1); PG8_BAR; PG8_SCHED;
            PG8_LDA(At, 0, 1); PG8_STAGE(PG8_SB(0, 0), b2, voffB); PG8_STAGE(PG8_SB(0, 1), b2 + hstep, voffB); PG8_STAGE(PG8_SA(0, 0), a2, voffA);
            PG8_WAIT_V(8); PG8_WAIT_L(0); PG8_BAR; PG8_MMA(1, 0, At, B0); PG8_MMA(1, 1, At, B1); PG8_BAR; PG8_SCHED;
            PG8_LDB(B0, 1, 0); PG8_LDB(B1, 1, 1); PG8_SCHED; PG8_LDA(At, 1, 0); PG8_STAGE(PG8_SA(0, 1), a2 + hstep, voffA);
            PG8_WAIT_V(8); PG8_WAIT_L(0); PG8_BAR; PG8_MMA(0, 0, At, B0); PG8_MMA(0, 1, At, B1); PG8_BAR; PG8_SCHED;
            PG8_LDA(At, 1, 1); PG8_STAGE(PG8_SB(1, 0), b3, voffB); PG8_STAGE(PG8_SB(1, 1), b3 + hstep, voffB); PG8_STAGE(PG8_SA(1, 0), a3, voffA);
            PG8_WAIT_V(8); PG8_WAIT_L(0); PG8_BAR; PG8_MMA(1, 0, At, B0); PG8_MMA(1, 1, At, B1); PG8_BAR; PG8_SCHED;
            } else {
            PG8_LDB(B0, 0, 0); PG8_SCHED; PG8_LDA(At, 0, 0); PG8_STAGE(PG8_SA(1, 1), a1 + hstep, voffA);
            PG8_WAIT_L(8); PG8_BAR; PG8_WAIT_L(0); PG8_MMA(0, 0, At, B0); PG8_BAR; PG8_SCHED;
            PG8_LDB(B1, 0, 1); PG8_STAGE(PG8_SB(0, 0), b2, voffB);
            PG8_BAR; PG8_WAIT_L(0); PG8_MMA(0, 1, At, B1); PG8_BAR;
            PG8_LDA(At, 0, 1); PG8_STAGE(PG8_SA(0, 0), a2, voffA);
            PG8_BAR; PG8_WAIT_L(0); PG8_MMA(1, 0, At, B0); PG8_BAR; PG8_SCHED;
            PG8_STAGE(PG8_SB(0, 1), b2 + hstep, voffB);
            PG8_WAIT_V(6); PG8_BAR; PG8_MMA(1, 1, At, B1); PG8_BAR;
            PG8_LDB(B0, 1, 0); PG8_SCHED; PG8_LDA(At, 1, 0); PG8_STAGE(PG8_SA(0, 1), a2 + hstep, voffA);
            PG8_WAIT_L(8); PG8_BAR; PG8_WAIT_L(0); PG8_MMA(0, 0, At, B0); PG8_BAR; PG8_SCHED;
            PG8_LDB(B1, 1, 1); PG8_STAGE(PG8_SB(1, 0), b3, voffB);
            PG8_BAR; PG8_WAIT_L(0); PG8_MMA(0, 1, At, B1); PG8_BAR;
            PG8_LDA(At, 1, 1); PG8_STAGE(PG8_SA(1, 0), a3, voffA);
            PG8_BAR; PG8_WAIT_L(0); PG8_MMA(1, 0, At, B0); PG8_BAR; PG8_SCHED;
            PG8_STAGE(PG8_SB(1, 1), b3 + hstep, voffB);
            PG8_WAIT_V(6); PG8_BAR; PG8_MMA(1, 1, At, B1); PG8_BAR;
            }
        }
        if constexpr (ALIGN_EPI) { if (wr == 0) PG8_BAR; }
        if constexpr (!Epi::AFTER_DRAIN) { E(acc, cur, wr, wc, fr, fq); S.done(cur); }
        if (!has_next) break;
#pragma unroll
        for (int a = 0; a < 2; ++a)
#pragma unroll
            for (int b = 0; b < 2; ++b)
#pragma unroll
                for (int m = 0; m < 4; ++m)
#pragma unroll
                    for (int n = 0; n < 2; ++n) acc[a][b][m][n] = (f32x4){0.f, 0.f, 0.f, 0.f};
        cur = nxt; cA = nA; cB = nB; ++ui;
        if constexpr (ALIGN_EPI) { if (wr == 1) PG8_BAR; }
    }
    PG8_WAIT_V(0);
    if constexpr (!ALIGN_EPI) { if (wr == 0) PG8_BAR; }
    PG8_BAR;
    if constexpr (Epi::AFTER_DRAIN) { E.fused(acc, cur, wr, wc, fr, fq, lds, wid, lane); S.done(cur); }
#undef PG8_SA
#undef PG8_SB
#undef PG8_STAGE
#undef PG8_LDA
#undef PG8_LDB
#undef PG8_MMA
#undef PG8_WAIT_V
#undef PG8_WAIT_L
#undef PG8_BAR
#undef PG8_SCHED
}
}

#ifndef DUP_PHASE
#define DUP_PHASE (-1)
#endif
constexpr int NWAVES = 8;
constexpr int DM = 2048, SEQ = 8192, LT = 8256, NPROJ = 8192, DFF = 5632, PADM = 64  , PADF = 48, NCHUNK = LT / 64;
constexpr size_t MiB = 1u << 20;
constexpr size_t WS_CTL = 0, CTL_ZERO_BYTES = 64 * 1024;
constexpr size_t WS_LB = 1 * MiB;
constexpr size_t WS_ST0 = 1 * MiB + 64 * 1024;
constexpr size_t WS_ST1 = 1 * MiB + 192 * 1024;
constexpr size_t WS_HM = 1 * MiB + 320 * 1024;
constexpr size_t WS_LG = 1 * MiB + 512 * 1024;
constexpr size_t WS_FH = 34 * MiB, WS_CH = 42 * MiB, WS_FR = 50 * MiB, WS_CR = 58 * MiB;
constexpr size_t WS_WIN = 2 * MiB;
constexpr size_t WS_WOUT = 2 * MiB;
constexpr size_t WS_WDOWN = 10 * MiB;
constexpr size_t WS_H0B = 34 * MiB;
constexpr size_t WS_MIX = 34 * MiB;
constexpr size_t WS_H1B = 34 * MiB;
constexpr size_t WS_PROJ = 66 * MiB;
constexpr size_t WS_Z = 66 * MiB;
constexpr size_t WS_ACT = 130 * MiB;
constexpr size_t WS_LOGF = 195 * MiB;
constexpr size_t WS_WGU = 228 * MiB;
constexpr size_t WS_END = 272 * MiB;
static_assert(WS_PROJ + (size_t)LT * NPROJ * 2 <= WS_LOGF && WS_LOGF + (size_t)LT * 1024 * 4 <= WS_WGU && WS_WGU + (size_t)2 * DFF * DM * 2 <= WS_END, "ws map");
static_assert(WS_ACT + (size_t)SEQ * DFF * 2 <= WS_WGU && WS_Z + (size_t)SEQ * DM * 4 <= WS_ACT && WS_WDOWN + (size_t)DM * DFF * 2 <= WS_H0B, "ws map 2");
constexpr size_t DO_RC = 0, DO_RS = (size_t)LT * 128 * 4;
constexpr int CW_BAR = 1024;
constexpr int RING_OFF = 0, RING_BYTES = 131072, LDSCTL_OFF = RING_BYTES, MISC_OFF = LDSCTL_OFF + 320, LDS_BYTES = 147456;

#define GAS __attribute__((address_space(1)))
#define LAS __attribute__((address_space(3)))
typedef unsigned short bf16;
typedef unsigned v4u __attribute__((ext_vector_type(4)));
typedef unsigned v2u __attribute__((ext_vector_type(2)));
typedef float f32x4 __attribute__((ext_vector_type(4)));
typedef short bf16x8 __attribute__((ext_vector_type(8)));
typedef short bf16x4 __attribute__((ext_vector_type(4)));
typedef GAS unsigned gu32;
#define RLX_AGENT __ATOMIC_RELAXED, __HIP_MEMORY_SCOPE_AGENT
#define LDS_WAIT() asm volatile("s_waitcnt lgkmcnt(0)" ::: "memory")
__device__ __forceinline__ float bf2f(bf16 v) { return __uint_as_float((unsigned)v << 16); }
__device__ __forceinline__ unsigned f2bf(float f) { unsigned u = __builtin_bit_cast(unsigned, f); return (u + 0x7fffu + ((u >> 16) & 1u)) >> 16; }
__device__ __forceinline__ unsigned pk2(float lo, float hi) { return f2bf(lo) | (f2bf(hi) << 16); }
using pg8::fexp; using pg8::silu_f; using pg8::sigmoid_f;

#define XB_TMO      128
#define XB_XCNT(j)  (256  + 64 * (j))
#define XB_XSUB(j)  (1280 + 64 * (j))
#define XB_XGEN(j)  (2304 + 64 * (j))
#define XB_TOP      3328
#define XB_TOPGEN   3392
#define XCD_BAR_WORDS 3456
#define XB_SPIN_CAP (1u << 18)

__device__ __forceinline__ unsigned xb_ld(unsigned* p)              { return __hip_atomic_load(p, __ATOMIC_RELAXED, __HIP_MEMORY_SCOPE_AGENT); }
__device__ __forceinline__ unsigned xb_add(unsigned* p, unsigned v) { return __hip_atomic_fetch_add(p, v, __ATOMIC_RELAXED, __HIP_MEMORY_SCOPE_AGENT); }
__device__ __forceinline__ unsigned xb_xcc_id() { return (unsigned)__builtin_amdgcn_s_getreg((3 << 11) | 20) & 0xFu; }
#define XB_SPIN(cond, bar) do { unsigned _sp = 0; while (cond) { __builtin_amdgcn_s_sleep(1); \
    if ((++_sp & 255u) == 0u) { if (xb_ld(&(bar)[XB_TMO])) break; if (_sp > XB_SPIN_CAP) { atomicAdd(&(bar)[XB_TMO], 1u); break; } } } } while (0)

struct XcdBarrier {
    unsigned* bar; unsigned x;
    volatile LAS unsigned* st;
};

__device__ __forceinline__ XcdBarrier xcd_barrier_post(unsigned* bar, volatile LAS unsigned* st) {
    XcdBarrier b; b.bar = bar; b.x = xb_xcc_id(); b.st = st;
    if (threadIdx.x == 0) (void)xb_add(&bar[XB_XCNT(b.x)], 1u);
    return b;
}
__device__ __forceinline__ void xcd_barrier_complete(unsigned* bar, unsigned x, unsigned& nloc, unsigned& nx) {
    const unsigned G = gridDim.x * gridDim.y * gridDim.z;
    unsigned sum, cnt, mine, sp = 0u;
    for (;;) {
        sum = 0u; cnt = 0u; mine = 0u;
#pragma unroll
        for (unsigned j = 0; j < 16; ++j) { const unsigned c = xb_ld(&bar[XB_XCNT(j)]); sum += c; cnt += (c > 0u) ? 1u : 0u; mine = (j == x) ? c : mine; }
        if (sum == G) break;
        __builtin_amdgcn_s_sleep(1);
        if ((++sp & 255u) == 0u) { if (xb_ld(&bar[XB_TMO])) break; if (sp > XB_SPIN_CAP) { atomicAdd(&bar[XB_TMO], 1u); break; } }
    }
    nloc = mine > 0u ? mine : 1u; nx = cnt > 0u ? cnt : 1u;
}

__device__ __forceinline__ void xcd_barrier(const XcdBarrier& b) {
    asm volatile("s_waitcnt vmcnt(0)" ::: "memory");
    __syncthreads();
    if (threadIdx.x == 0) {
        unsigned* bar = b.bar;
        __builtin_amdgcn_s_waitcnt(0);
        unsigned nloc = b.st[0], nx = b.st[1];
        if (nloc == 0u) { xcd_barrier_complete(bar, b.x, nloc, nx); b.st[0] = nloc; b.st[1] = nx; }
        const unsigned old = xb_add(&bar[XB_XSUB(b.x)], 1u);
        const unsigned gen = old / nloc;
        if (old + 1u == (gen + 1u) * nloc) {
            __builtin_amdgcn_fence(__ATOMIC_RELEASE, "agent");
            asm volatile("s_waitcnt vmcnt(0)" ::: "memory");
            const unsigned og = xb_add(&bar[XB_TOP], 1u);
            const unsigned tg = og / nx;
            if (og + 1u == (tg + 1u) * nx) xb_add(&bar[XB_TOPGEN], 1u);
            else XB_SPIN(xb_ld(&bar[XB_TOPGEN]) == tg, bar);
            __builtin_amdgcn_fence(__ATOMIC_ACQUIRE, "agent");
            xb_add(&bar[XB_XGEN(b.x)], 1u);
            asm volatile("s_waitcnt vmcnt(0)" ::: "memory");
        } else {
            XB_SPIN(xb_ld(&bar[XB_XGEN(b.x)]) == gen, bar);
            __builtin_amdgcn_fence(__ATOMIC_ACQUIRE, "agent");
            asm volatile("s_waitcnt vmcnt(0)" ::: "memory");
        }
    }
    __syncthreads();
}

struct Frame {
    LAS unsigned char* lds;
    volatile LAS unsigned* MISC;
    int tid, lane, wave, G;
    const float *x, *meta, *ln_in_g, *ln_in_b, *hlb, *w_in, *hg_ng, *ret_ng, *ret_nb, *w_out, *ln1_g, *ln1_b, *w_gate, *w_up, *w_down, *ln2_g, *ln2_b;
    float* out; unsigned char* ws;
};
__device__ __forceinline__ float wave_sum(float v) {
#pragma unroll
    for (int o = 1; o < 64; o <<= 1) v += __shfl_xor(v, o);
    return v;
}
template <int MAP> __device__ __forceinline__ void transpose_item(const float* W, int K, int N, bf16* WT, LAS float* scr, int item, int lane) {
    const int nblk = N / 32, kb = item / nblk, nb = item % nblk, k0 = 64 * kb, n0 = 32 * nb;
    const int rbase = (MAP == 0) ? n0 : (256 * (n0 >> 7) + (n0 & 127) + (MAP == 2 ? 128 : 0));
    f32x4 v[8];
#pragma unroll
    for (int i = 0; i < 8; ++i) v[i] = *(const GAS f32x4*)(W + (size_t)(k0 + (lane >> 3) + 8 * i) * N + n0 + 4 * (lane & 7));
#pragma unroll
    for (int i = 0; i < 8; ++i)
#pragma unroll
        for (int e = 0; e < 4; ++e) scr[((lane >> 3) + 8 * i) * 33 + 4 * (lane & 7) + e] = v[i][e];
    LDS_WAIT(); asm volatile("" ::: "memory");
    const int c = lane & 7;
#pragma unroll
    for (int j = 0; j < 4; ++j) { const int n = (lane >> 3) + 8 * j; const LAS float* s = scr + (8 * c) * 33 + n;
        v4u o; o.x = pk2(s[0 * 33], s[1 * 33]); o.y = pk2(s[2 * 33], s[3 * 33]); o.z = pk2(s[4 * 33], s[5 * 33]); o.w = pk2(s[6 * 33], s[7 * 33]);
        *(GAS v4u*)(WT + (size_t)(rbase + n) * K + k0 + 8 * c) = o; }
    LDS_WAIT(); asm volatile("" ::: "memory");
}
__device__ __forceinline__ void ln_row(const float* xrow, bool zero_in, const float* g, const float* b, bf16* ob, float* of, float* st, int lane) {
    const GAS f32x4* xr = (const GAS f32x4*)xrow + lane;
    f32x4 v[8]; float s = 0.f;
#pragma unroll
    for (int j = 0; j < 8; ++j) { v[j] = zero_in ? (f32x4){0.f, 0.f, 0.f, 0.f} : xr[64 * j]; s += (v[j].x + v[j].y) + (v[j].z + v[j].w); }
    const float mean = wave_sum(s) * (1.f / DM); float s2 = 0.f;
#pragma unroll
    for (int j = 0; j < 8; ++j) { v[j] = v[j] - mean; s2 += (v[j].x * v[j].x + v[j].y * v[j].y) + (v[j].z * v[j].z + v[j].w * v[j].w); }
    const float rstd = 1.f / sqrtf(wave_sum(s2) * (1.f / DM) + 1e-5f);
#pragma unroll
    for (int j = 0; j < 8; ++j) {
        const f32x4 gv = *((const GAS f32x4*)g + lane + 64 * j), bv = *((const GAS f32x4*)b + lane + 64 * j);
        const f32x4 y = v[j] * rstd * gv + bv;
        if (ob) *((GAS v2u*)ob + lane + 64 * j) = (v2u){pk2(y.x, y.y), pk2(y.z, y.w)};
        if (of) *((GAS f32x4*)of + lane + 64 * j) = y;
    }
    if (st && lane == 0) { st[0] = mean; st[1] = rstd; }
}

#define TR4(d0, d1, d2, d3, base, o0, o1, o2, o3) asm volatile( \
    "ds_read_b64_tr_b16 %0, %4 offset:%5\n\tds_read_b64_tr_b16 %1, %4 offset:%6\n\tds_read_b64_tr_b16 %2, %4 offset:%7\n\tds_read_b64_tr_b16 %3, %4 offset:%8\n\ts_waitcnt lgkmcnt(0)" \
    : "=&v"(d0), "=&v"(d1), "=&v"(d2), "=&v"(d3) : "v"(base), "i"(o0), "i"(o1), "i"(o2), "i"(o3) : "memory")
#define TR8(d0, d1, d2, d3, d4, d5, d6, d7, base, o0, o1, o2, o3, o4, o5, o6, o7) asm volatile( \
    "ds_read_b64_tr_b16 %0, %8 offset:%9\n\tds_read_b64_tr_b16 %1, %8 offset:%10\n\tds_read_b64_tr_b16 %2, %8 offset:%11\n\tds_read_b64_tr_b16 %3, %8 offset:%12\n\t" \
    "ds_read_b64_tr_b16 %4, %8 offset:%13\n\tds_read_b64_tr_b16 %5, %8 offset:%14\n\tds_read_b64_tr_b16 %6, %8 offset:%15\n\tds_read_b64_tr_b16 %7, %8 offset:%16\n\ts_waitcnt lgkmcnt(0)" \
    : "=&v"(d0), "=&v"(d1), "=&v"(d2), "=&v"(d3), "=&v"(d4), "=&v"(d5), "=&v"(d6), "=&v"(d7) \
    : "v"(base), "i"(o0), "i"(o1), "i"(o2), "i"(o3), "i"(o4), "i"(o5), "i"(o6), "i"(o7) : "memory")
__device__ __forceinline__ bf16x8 cat4(bf16x4 lo, bf16x4 hi) { bf16x8 r; r[0] = lo[0]; r[1] = lo[1]; r[2] = lo[2]; r[3] = lo[3]; r[4] = hi[0]; r[5] = hi[1]; r[6] = hi[2]; r[7] = hi[3]; return r; }
#define MFMA16(a, b, c) __builtin_amdgcn_mfma_f32_16x16x32_bf16((a), (b), (c), 0, 0, 0)
#define LBAR() do { asm volatile("s_waitcnt lgkmcnt(0)" ::: "memory"); __builtin_amdgcn_s_barrier(); asm volatile("" ::: "memory"); } while (0)
using pg8::cvt_pk_bf16;
__device__ __forceinline__ float ex2(float x) { return __builtin_amdgcn_exp2f(x); }
__device__ __forceinline__ bf16x8 pack8(const f32x4& a, const f32x4& b) {
    union { unsigned u[4]; bf16x8 v; } r; r.u[0] = cvt_pk_bf16(a[0], a[1]); r.u[1] = cvt_pk_bf16(a[2], a[3]); r.u[2] = cvt_pk_bf16(b[0], b[1]); r.u[3] = cvt_pk_bf16(b[2], b[3]); return r.v; }

constexpr int HG_G = 16, RT_G = 8;
__host__ __device__ __forceinline__ int hg_cb(int g) { return g == 0 ? 0 : 8 * g + 1; }
__host__ __device__ __forceinline__ int rt_cb(int g) { return g == 0 ? 0 : 16 * g + 1; }

constexpr int HQS = 272;
constexpr int H_QD = 0, H_KD = H_QD + 64 * HQS, H_V = H_KD + 64 * HQS, H_SB = H_V + 64 * HQS, H_EL = H_SB + 128 * HQS, H_TOT = H_EL + 512, H_END = H_TOT + 16 * 128 * 4;
static_assert(H_END <= RING_BYTES, "hgrn lds");
struct HRegs { f32x4 lf[4]; v2u qn[4], kn[4]; v4u vn[2]; };
struct HCtx { LAS unsigned char* lds; const bf16* PROJ; const float* LOGF; float* HGO; int h, tid, lane, w, r16, q4, tq, vg, a_, p_, cg, rg; unsigned lbase; };
template <int MODE> __device__ __forceinline__ void h_load(HRegs& R, const HCtx& X, int c) {
    const int t0 = c * 64;
#pragma unroll
    for (int i = 0; i < 4; ++i) { const size_t row = (size_t)(t0 + 4 * X.rg + i);
        R.lf[i] = *(const f32x4*)(X.LOGF + row * 1024 + X.h * 128 + 4 * X.cg);
        if (MODE == 1) R.qn[i] = *(const v2u*)(X.PROJ + row * NPROJ + X.h * 128 + 4 * X.cg);
        R.kn[i] = *(const v2u*)(X.PROJ + row * NPROJ + 1024 + X.h * 128 + 4 * X.cg); }
#pragma unroll
    for (int i = 0; i < 2; ++i) { const int id = X.tid + 512 * i; R.vn[i] = *(const v4u*)(X.PROJ + (size_t)(t0 + (id >> 4)) * NPROJ + 2048 + X.h * 128 + (id & 15) * 8); }
}
template <int MODE> __device__ __forceinline__ void h_step(HRegs& R, const HCtx& X, f32x4 (&S)[2][4], f32x4& lgsum, int c, bool do_load, int c_load) {
    LAS unsigned char* lds = X.lds; const int cg = X.cg, rg = X.rg, r16 = X.r16, q4 = X.q4, tq = X.tq, vg = X.vg;
    const int t0 = c * 64;
    f32x4 cs[4]; f32x4 run = (f32x4){0.f, 0.f, 0.f, 0.f};
#pragma unroll
    for (int i = 0; i < 4; ++i) { run = run + R.lf[i]; cs[i] = run; }
    *(LAS f32x4*)(lds + H_TOT + (rg * 128 + 4 * cg) * 4) = run;
    LBAR();
    f32x4 off = (f32x4){0.f, 0.f, 0.f, 0.f};
    for (int r2 = 0; r2 < 2 * X.w; ++r2) off = off + *(const LAS f32x4*)(lds + H_TOT + (r2 * 128 + 4 * cg) * 4);
    if (rg & 1) off = off + *(const LAS f32x4*)(lds + H_TOT + ((rg - 1) * 128 + 4 * cg) * 4);
#pragma unroll
    for (int i = 0; i < 4; ++i) {
        const f32x4 cum = off + cs[i];
        const v2u kn = R.kn[i];
        const float k0 = __uint_as_float(kn.x << 16), k1 = __uint_as_float(kn.x & 0xffff0000u), k2 = __uint_as_float(kn.y << 16), k3 = __uint_as_float(kn.y & 0xffff0000u);
        *(LAS v2u*)(lds + H_KD + (4 * rg + i) * HQS + 8 * cg) = (v2u){cvt_pk_bf16(k0 * ex2(-cum[0]), k1 * ex2(-cum[1])), cvt_pk_bf16(k2 * ex2(-cum[2]), k3 * ex2(-cum[3]))};
        if (MODE == 1) {
            const v2u qn = R.qn[i];
            const float q0 = __uint_as_float(qn.x << 16), q1 = __uint_as_float(qn.x & 0xffff0000u), q2 = __uint_as_float(qn.y << 16), q3 = __uint_as_float(qn.y & 0xffff0000u);
            *(LAS v2u*)(lds + H_QD + (4 * rg + i) * HQS + 8 * cg) = (v2u){cvt_pk_bf16(q0 * ex2(cum[0]), q1 * ex2(cum[1])), cvt_pk_bf16(q2 * ex2(cum[2]), q3 * ex2(cum[3]))};
        }
    }
    if (rg == 15) { const f32x4 last = off + run; lgsum = lgsum + last; *(LAS f32x4*)(lds + H_EL + 16 * cg) = (f32x4){ex2(last[0]), ex2(last[1]), ex2(last[2]), ex2(last[3])}; }
#pragma unroll
    for (int i = 0; i < 2; ++i) { const int id = X.tid + 512 * i; *(LAS v4u*)(lds + H_V + (id >> 4) * HQS + (id & 15) * 16) = R.vn[i]; }
    if (MODE == 1) {
#pragma unroll
        for (int u = 0; u < 2; ++u)
#pragma unroll
            for (int vt = 0; vt < 4; ++vt)
                *(LAS v2u*)(lds + H_SB + (16 * (4 * vg + vt) + r16) * HQS + (16 * (2 * tq + u) + 4 * q4) * 2) = (v2u){cvt_pk_bf16(S[u][vt][0], S[u][vt][1]), cvt_pk_bf16(S[u][vt][2], S[u][vt][3])};
    }
    LBAR();
    if (do_load) h_load<MODE>(R, X, c_load);
    if (MODE == 1) {
        bf16x8 qf[4];
#pragma unroll
        for (int kb = 0; kb < 4; ++kb) qf[kb] = *(const LAS bf16x8*)(lds + H_QD + (16 * tq + r16) * HQS + (32 * kb + 8 * q4) * 2);
        f32x4 o[4];
#pragma unroll
        for (int vt = 0; vt < 4; ++vt) {
            o[vt] = (f32x4){0.f, 0.f, 0.f, 0.f};
#pragma unroll
            for (int kb = 0; kb < 4; ++kb) o[vt] = MFMA16(qf[kb], *(const LAS bf16x8*)(lds + H_SB + (16 * (4 * vg + vt) + r16) * HQS + (32 * kb + 8 * q4) * 2), o[vt]);
        }
#pragma unroll
        for (int p = 0; p < 2; ++p) {
            if (2 * p <= tq) {
                f32x4 xa = (f32x4){0.f, 0.f, 0.f, 0.f}, xb = xa;
#pragma unroll
                for (int kb = 0; kb < 4; ++kb) xa = MFMA16(*(const LAS bf16x8*)(lds + H_KD + (32 * p + r16) * HQS + (32 * kb + 8 * q4) * 2), qf[kb], xa);
                if (2 * p == tq) {
#pragma unroll
                    for (int i = 0; i < 4; ++i) if (4 * q4 + i > r16) xa[i] = 0.f;
                }
                if (2 * p + 1 <= tq) {
#pragma unroll
                    for (int kb = 0; kb < 4; ++kb) xb = MFMA16(*(const LAS bf16x8*)(lds + H_KD + (32 * p + 16 + r16) * HQS + (32 * kb + 8 * q4) * 2), qf[kb], xb);
                    if (2 * p + 1 == tq) {
#pragma unroll
                        for (int i = 0; i < 4; ++i) if (4 * q4 + i > r16) xb[i] = 0.f;
                    }
                }
                const bf16x8 pa = pack8(xa, xb);
                bf16x4 e0, e1, e2, e3, e4, e5, e6, e7;
                const unsigned va = X.lbase + H_V + (32 * p + 4 * q4 + X.a_) * HQS + (64 * vg + 4 * X.p_) * 2;
                TR8(e0, e1, e2, e3, e4, e5, e6, e7, va, 0, 16 * HQS, 32, 16 * HQS + 32, 64, 16 * HQS + 64, 96, 16 * HQS + 96);
                o[0] = MFMA16(pa, cat4(e0, e1), o[0]); o[1] = MFMA16(pa, cat4(e2, e3), o[1]); o[2] = MFMA16(pa, cat4(e4, e5), o[2]); o[3] = MFMA16(pa, cat4(e6, e7), o[3]);
            }
        }
        if (c > 0) {
#pragma unroll
            for (int vt = 0; vt < 4; ++vt)
#pragma unroll
                for (int i = 0; i < 4; ++i) X.HGO[(size_t)(t0 - PADM + 16 * tq + 4 * q4 + i) * 1024 + X.h * 128 + 16 * (4 * vg + vt) + r16] = o[vt][i];
        }
    }
    {
        bf16x4 a0, a1, a2, a3, a4, a5, a6, a7;
        const unsigned ka = X.lbase + H_KD + (8 * q4 + X.a_) * HQS + (32 * tq + 4 * X.p_) * 2;
        TR8(a0, a1, a2, a3, a4, a5, a6, a7, ka, 0, 4 * HQS, 32 * HQS, 36 * HQS, 32, 4 * HQS + 32, 32 * HQS + 32, 36 * HQS + 32);
        const bf16x8 A00 = cat4(a0, a1), A01 = cat4(a2, a3), A10 = cat4(a4, a5), A11 = cat4(a6, a7);
        const unsigned va = X.lbase + H_V + (8 * q4 + X.a_) * HQS + (64 * vg + 4 * X.p_) * 2;
#pragma unroll
        for (int vp = 0; vp < 2; ++vp) {
            bf16x4 b0, b1, b2, b3, b4, b5, b6, b7;
            if (vp == 0) TR8(b0, b1, b2, b3, b4, b5, b6, b7, va, 0, 4 * HQS, 32 * HQS, 36 * HQS, 32, 4 * HQS + 32, 32 * HQS + 32, 36 * HQS + 32);
            else         TR8(b0, b1, b2, b3, b4, b5, b6, b7, va, 64, 4 * HQS + 64, 32 * HQS + 64, 36 * HQS + 64, 96, 4 * HQS + 96, 32 * HQS + 96, 36 * HQS + 96);
            const bf16x8 B00 = cat4(b0, b1), B01 = cat4(b2, b3), B10 = cat4(b4, b5), B11 = cat4(b6, b7);
            S[0][2 * vp] = MFMA16(A00, B00, S[0][2 * vp]); S[0][2 * vp] = MFMA16(A01, B01, S[0][2 * vp]);
            S[0][2 * vp + 1] = MFMA16(A00, B10, S[0][2 * vp + 1]); S[0][2 * vp + 1] = MFMA16(A01, B11, S[0][2 * vp + 1]);
            S[1][2 * vp] = MFMA16(A10, B00, S[1][2 * vp]); S[1][2 * vp] = MFMA16(A11, B01, S[1][2 * vp]);
            S[1][2 * vp + 1] = MFMA16(A10, B10, S[1][2 * vp + 1]); S[1][2 * vp + 1] = MFMA16(A11, B11, S[1][2 * vp + 1]);
        }
#pragma unroll
        for (int u = 0; u < 2; ++u) { const f32x4 el = *(const LAS f32x4*)(lds + H_EL + (16 * (2 * tq + u) + 4 * q4) * 4);
#pragma unroll
            for (int vt = 0; vt < 4; ++vt) S[u][vt] = S[u][vt] * el; }
    }
}
template <int MODE> __device__ __forceinline__ void hgrn_scan(LAS unsigned char* lds, const bf16* __restrict__ PROJ, const float* __restrict__ LOGF, float* __restrict__ HGO,
                                                              float* __restrict__ FST, float* __restrict__ LG, int g, int h) {
    int tid_ = threadIdx.x; asm volatile("" : "+v"(tid_));
    HCtx X; X.lds = lds; X.PROJ = PROJ; X.LOGF = LOGF; X.HGO = HGO; X.h = h;
    X.tid = tid_; X.lane = tid_ & 63; X.w = __builtin_amdgcn_readfirstlane(tid_ >> 6);
    X.r16 = X.lane & 15; X.q4 = X.lane >> 4; X.tq = X.w >> 1; X.vg = X.w & 1;
    X.a_ = (X.lane & 15) >> 2; X.p_ = X.lane & 3; X.cg = tid_ & 31; X.rg = tid_ >> 5;
    X.lbase = (unsigned)(size_t)lds;
    const int cb = hg_cb(g), ce = hg_cb(g + 1);
    f32x4 S[2][4]; f32x4 lgsum = (f32x4){0.f, 0.f, 0.f, 0.f};
#pragma unroll
    for (int u = 0; u < 2; ++u)
#pragma unroll
        for (int vt = 0; vt < 4; ++vt) S[u][vt] = (f32x4){0.f, 0.f, 0.f, 0.f};
    if (MODE == 1) {
#pragma unroll 2
        for (int gi = 0; gi < g; ++gi) {
            const float* fb = FST + (size_t)(gi * 8 + h) * 16384 + (size_t)X.w * 2048 + X.lane * 4;
#pragma unroll
            for (int u = 0; u < 2; ++u) {
                const f32x4 lg = *(const f32x4*)(LG + (size_t)(gi * 8 + h) * 128 + 16 * (2 * X.tq + u) + 4 * X.q4);
                const f32x4 d = (f32x4){ex2(lg[0]), ex2(lg[1]), ex2(lg[2]), ex2(lg[3])};
#pragma unroll
                for (int vt = 0; vt < 4; ++vt) S[u][vt] = S[u][vt] * d + *(const f32x4*)(fb + (u * 4 + vt) * 256);
            }
        }
    }
    HRegs A, B;
    h_load<MODE>(A, X, cb);
    if (cb + 1 < ce) h_load<MODE>(B, X, cb + 1);
    for (int c = cb; c < ce; c += 2) {
        h_step<MODE>(A, X, S, lgsum, c, c + 2 < ce, c + 2);
        if (c + 1 < ce) h_step<MODE>(B, X, S, lgsum, c + 1, c + 3 < ce, c + 3);
    }
    if (MODE == 0) {
        float* fb = FST + (size_t)(g * 8 + h) * 16384 + (size_t)X.w * 2048 + X.lane * 4;
#pragma unroll
        for (int u = 0; u < 2; ++u)
#pragma unroll
            for (int vt = 0; vt < 4; ++vt) *(f32x4*)(fb + (u * 4 + vt) * 256) = S[u][vt];
        if (X.rg == 15) *(f32x4*)(LG + (size_t)(g * 8 + h) * 128 + 4 * X.cg) = lgsum;
    }
    LBAR();
}

constexpr int RQS = 528, RVS = 144;
constexpr int R_Q = 0, R_K = R_Q + 64 * RQS, R_VD = R_K + 64 * RQS, R_RB = R_VD + 64 * RVS, R_END = R_RB + 64 * RQS;
static_assert(R_END <= RING_BYTES, "ret lds");
struct RRegs { v4u qn[4], kn[4]; v4u vn; };
struct RCtx { LAS unsigned char* lds; const bf16* PROJ; float* RETO; int h, j, tid, lane, w, r16, q4, tq, vg, a_, p_; unsigned lbase; float l2g, g64; };
template <int MODE> __device__ __forceinline__ void r_load(RRegs& R, const RCtx& X, int c) {
    const int t0 = c * 64;
#pragma unroll
    for (int i = 0; i < 4; ++i) { const int id = X.tid + 512 * i, row = id >> 5, ch = id & 31;
        if (MODE == 1) R.qn[i] = *(const v4u*)(X.PROJ + (size_t)(t0 + row) * NPROJ + 4096 + X.h * 256 + ch * 8);
        R.kn[i] = *(const v4u*)(X.PROJ + (size_t)(t0 + row) * NPROJ + 5120 + X.h * 256 + ch * 8); }
    R.vn = *(const v4u*)(X.PROJ + (size_t)(t0 + (X.tid >> 3)) * NPROJ + 6144 + X.h * 256 + 64 * X.j + (X.tid & 7) * 8);
}
template <int MODE> __device__ __forceinline__ void r_step(RRegs& Rg, const RCtx& X, f32x4 (&R)[4][2], int c, bool do_load, int c_load) {
    LAS unsigned char* lds = X.lds; const int r16 = X.r16, q4 = X.q4, tq = X.tq, vg = X.vg; const float l2g = X.l2g;
    const int t0 = c * 64;
    LBAR();
#pragma unroll
    for (int i = 0; i < 4; ++i) { const int id = X.tid + 512 * i, row = id >> 5, ch = id & 31;
        if (MODE == 1) *(LAS v4u*)(lds + R_Q + row * RQS + ch * 16) = Rg.qn[i];
        *(LAS v4u*)(lds + R_K + row * RQS + ch * 16) = Rg.kn[i]; }
    { const int vs = X.tid >> 3, vq = X.tid & 7; const v4u vn = Rg.vn;
      const float dec = ex2((float)(63 - vs) * l2g); v4u wv;
#pragma unroll
      for (int e = 0; e < 4; ++e) wv[e] = cvt_pk_bf16(__uint_as_float(vn[e] << 16) * dec, __uint_as_float(vn[e] & 0xffff0000u) * dec);
      *(LAS v4u*)(lds + R_VD + vs * RVS + vq * 16) = wv; }
    if (MODE == 1) {
#pragma unroll
        for (int u = 0; u < 4; ++u)
#pragma unroll
            for (int vt = 0; vt < 2; ++vt)
                *(LAS v2u*)(lds + R_RB + (16 * (2 * vg + vt) + r16) * RQS + (16 * (4 * tq + u) + 4 * q4) * 2) = (v2u){cvt_pk_bf16(R[u][vt][0], R[u][vt][1]), cvt_pk_bf16(R[u][vt][2], R[u][vt][3])};
    }
    LBAR();
    if (do_load) r_load<MODE>(Rg, X, c_load);
    if (MODE == 1) {
        bf16x8 qf[8];
#pragma unroll
        for (int kb = 0; kb < 8; ++kb) qf[kb] = *(const LAS bf16x8*)(lds + R_Q + (16 * tq + r16) * RQS + (32 * kb + 8 * q4) * 2);
        f32x4 o3[2], o2[2];
#pragma unroll
        for (int vt = 0; vt < 2; ++vt) {
            o3[vt] = (f32x4){0.f, 0.f, 0.f, 0.f}; o2[vt] = o3[vt];
#pragma unroll
            for (int kb = 0; kb < 8; ++kb) o3[vt] = MFMA16(qf[kb], *(const LAS bf16x8*)(lds + R_RB + (16 * (2 * vg + vt) + r16) * RQS + (32 * kb + 8 * q4) * 2), o3[vt]);
        }
#pragma unroll
        for (int p = 0; p < 2; ++p) {
            if (2 * p <= tq) {
                f32x4 xa = (f32x4){0.f, 0.f, 0.f, 0.f}, xb = xa;
#pragma unroll
                for (int kb = 0; kb < 8; ++kb) xa = MFMA16(*(const LAS bf16x8*)(lds + R_K + (32 * p + r16) * RQS + (32 * kb + 8 * q4) * 2), qf[kb], xa);
                if (2 * p == tq) {
#pragma unroll
                    for (int i = 0; i < 4; ++i) if (4 * q4 + i > r16) xa[i] = 0.f;
                }
                if (2 * p + 1 <= tq) {
#pragma unroll
                    for (int kb = 0; kb < 8; ++kb) xb = MFMA16(*(const LAS bf16x8*)(lds + R_K + (32 * p + 16 + r16) * RQS + (32 * kb + 8 * q4) * 2), qf[kb], xb);
                    if (2 * p + 1 == tq) {
#pragma unroll
                        for (int i = 0; i < 4; ++i) if (4 * q4 + i > r16) xb[i] = 0.f;
                    }
                }
                const bf16x8 pa = pack8(xa, xb);
                bf16x4 e0, e1, e2, e3;
                const unsigned va = X.lbase + R_VD + (32 * p + 4 * q4 + X.a_) * RVS + (32 * vg + 4 * X.p_) * 2;
                TR4(e0, e1, e2, e3, va, 0, 16 * RVS, 32, 16 * RVS + 32);
                o2[0] = MFMA16(pa, cat4(e0, e1), o2[0]); o2[1] = MFMA16(pa, cat4(e2, e3), o2[1]);
            }
        }
        if (c > 0) {
#pragma unroll
            for (int i = 0; i < 4; ++i) {
                const int tl = 16 * tq + 4 * q4 + i; const float f3 = ex2((float)(tl + 1) * l2g), f2 = ex2((float)(tl - 63) * l2g);
#pragma unroll
                for (int vt = 0; vt < 2; ++vt) X.RETO[(size_t)(t0 - PADM + tl) * 1024 + X.h * 256 + 64 * X.j + 16 * (2 * vg + vt) + r16] = f3 * o3[vt][i] + f2 * o2[vt][i];
            }
        }
    }
    {
        bf16x4 b0, b1, b2, b3, b4, b5, b6, b7;
        const unsigned va = X.lbase + R_VD + (8 * q4 + X.a_) * RVS + (32 * vg + 4 * X.p_) * 2;
        TR8(b0, b1, b2, b3, b4, b5, b6, b7, va, 0, 4 * RVS, 32 * RVS, 36 * RVS, 32, 4 * RVS + 32, 32 * RVS + 32, 36 * RVS + 32);
        const bf16x8 B00 = cat4(b0, b1), B01 = cat4(b2, b3), B10 = cat4(b4, b5), B11 = cat4(b6, b7);
        const unsigned ka = X.lbase + R_K + (8 * q4 + X.a_) * RQS + (64 * tq + 4 * X.p_) * 2;
#pragma unroll
        for (int up = 0; up < 2; ++up) {
            bf16x4 a0, a1, a2, a3, a4, a5, a6, a7;
            if (up == 0) TR8(a0, a1, a2, a3, a4, a5, a6, a7, ka, 0, 4 * RQS, 32 * RQS, 36 * RQS, 32, 4 * RQS + 32, 32 * RQS + 32, 36 * RQS + 32);
            else         TR8(a0, a1, a2, a3, a4, a5, a6, a7, ka, 64, 4 * RQS + 64, 32 * RQS + 64, 36 * RQS + 64, 96, 4 * RQS + 96, 32 * RQS + 96, 36 * RQS + 96);
            const bf16x8 A00 = cat4(a0, a1), A01 = cat4(a2, a3), A10 = cat4(a4, a5), A11 = cat4(a6, a7);
#pragma unroll
            for (int vt = 0; vt < 2; ++vt) { R[2 * up][vt] = R[2 * up][vt] * X.g64; R[2 * up + 1][vt] = R[2 * up + 1][vt] * X.g64; }
            R[2 * up][0] = MFMA16(A00, B00, R[2 * up][0]); R[2 * up][0] = MFMA16(A01, B01, R[2 * up][0]);
            R[2 * up][1] = MFMA16(A00, B10, R[2 * up][1]); R[2 * up][1] = MFMA16(A01, B11, R[2 * up][1]);
            R[2 * up + 1][0] = MFMA16(A10, B00, R[2 * up + 1][0]); R[2 * up + 1][0] = MFMA16(A11, B01, R[2 * up + 1][0]);
            R[2 * up + 1][1] = MFMA16(A10, B10, R[2 * up + 1][1]); R[2 * up + 1][1] = MFMA16(A11, B11, R[2 * up + 1][1]);
        }
    }
}
template <int MODE> __device__ __forceinline__ void ret_scan(LAS unsigned char* lds, const bf16* __restrict__ PROJ, float* __restrict__ RETO, float* __restrict__ FST, int g, int h, int j) {
    int tid_ = threadIdx.x; asm volatile("" : "+v"(tid_));
    RCtx X; X.lds = lds; X.PROJ = PROJ; X.RETO = RETO; X.h = h; X.j = j;
    X.tid = tid_; X.lane = tid_ & 63; X.w = __builtin_amdgcn_readfirstlane(tid_ >> 6);
    X.r16 = X.lane & 15; X.q4 = X.lane >> 4; X.tq = X.w >> 1; X.vg = X.w & 1;
    X.a_ = (X.lane & 15) >> 2; X.p_ = X.lane & 3;
    X.lbase = (unsigned)(size_t)lds;
    X.l2g = log2f(1.0f - exp2f(-5.0f - (float)h)); X.g64 = ex2(64.0f * X.l2g);
    const int cb = rt_cb(g), ce = rt_cb(g + 1);
    f32x4 R[4][2];
#pragma unroll
    for (int u = 0; u < 4; ++u)
#pragma unroll
        for (int vt = 0; vt < 2; ++vt) R[u][vt] = (f32x4){0.f, 0.f, 0.f, 0.f};
    if (MODE == 1) {
#pragma unroll 2
        for (int gi = 0; gi < g; ++gi) {
            const float* fb = FST + (size_t)((gi * 4 + h) * 4 + j) * 16384 + (size_t)X.w * 2048 + X.lane * 4;
            const float d = ex2(64.0f * (float)(rt_cb(gi + 1) - rt_cb(gi)) * X.l2g);
#pragma unroll
            for (int u = 0; u < 4; ++u)
#pragma unroll
                for (int vt = 0; vt < 2; ++vt) R[u][vt] = R[u][vt] * d + *(const f32x4*)(fb + (u * 2 + vt) * 256);
        }
    }
    RRegs A, B;
    r_load<MODE>(A, X, cb);
    if (cb + 1 < ce) r_load<MODE>(B, X, cb + 1);
    for (int c = cb; c < ce; c += 2) {
        r_step<MODE>(A, X, R, c, c + 2 < ce, c + 2);
        if (c + 1 < ce) r_step<MODE>(B, X, R, c + 1, c + 3 < ce, c + 3);
    }
    if (MODE == 0) {
        float* fb = FST + (size_t)((g * 4 + h) * 4 + j) * 16384 + (size_t)X.w * 2048 + X.lane * 4;
#pragma unroll
        for (int u = 0; u < 4; ++u)
#pragma unroll
            for (int vt = 0; vt < 2; ++vt) *(f32x4*)(fb + (u * 2 + vt) * 256) = R[u][vt];
    }
    LBAR();
}

constexpr int HMS = 4096 + 16;
__device__ __forceinline__ void meta_proj(Frame& F, const bf16* __restrict__ WINT, const bf16* __restrict__ HM, bf16* PROJ, float* LOGF, const float* LB, const float* RC, const float* RS) {
    LAS unsigned char* hm = F.lds; LAS float* red = (LAS float*)(F.lds + 16 * HMS);
    for (int i = F.tid; i < 16 * 256; i += 512) *(LAS v4u*)(hm + (i >> 8) * HMS + (i & 255) * 16) = *((const v4u*)HM + i);
    __syncthreads();
    const int r16 = F.lane & 15, q4 = F.lane >> 4;
    const int r = F.tid >> 5, ci = F.tid & 31, t = PADF + r;
    for (int grp = blockIdx.x; grp < 256; grp += F.G) {
        int cbase, cstep, mode;
        if (grp < 128) { cbase = 32 * grp; cstep = 16; mode = cbase >> 10; }
        else if (grp < 192) { const int g2 = grp - 128, region = g2 >> 3, jj = g2 & 7; cbase = 4096 + region * 256 + 16 * jj; cstep = 128; mode = 4 + (region >> 2); }
        else { cbase = 6144 + 32 * (grp - 192); cstep = 16; mode = cbase >> 10; }
        f32x4 acc[2]; acc[0] = (f32x4){0.f, 0.f, 0.f, 0.f}; acc[1] = acc[0];
        const bf16* w0 = WINT + (size_t)(cbase + r16) * DM + 256 * F.wave + 8 * q4;
        const bf16* w1 = w0 + (size_t)cstep * DM;
#pragma unroll
        for (int ks = 0; ks < 8; ++ks) {
            const bf16x8 a = *(const LAS bf16x8*)(hm + r16 * HMS + (256 * F.wave + 32 * ks + 8 * q4) * 2);
            const bf16x8 b0 = *(const bf16x8*)(w0 + 32 * ks), b1 = *(const bf16x8*)(w1 + 32 * ks);
            acc[0] = MFMA16(a, b0, acc[0]); acc[1] = MFMA16(a, b1, acc[1]);
        }
        *(LAS f32x4*)(red + ((F.wave * 2 + 0) * 64 + F.lane) * 4) = acc[0];
        *(LAS f32x4*)(red + ((F.wave * 2 + 1) * 64 + F.lane) * 4) = acc[1];
        __syncthreads();
        float accv = 0.f;
#pragma unroll
        for (int w = 0; w < 8; ++w) accv += red[((w * 2 + (ci >> 4)) * 64 + (ci & 15) + 16 * (r >> 2)) * 4 + (r & 3)];
        const int col = cbase + (ci & 15) + cstep * (ci >> 4);
        const float partner = __shfl_xor(accv, 16);
        float o = accv;
        if (mode == 0) o = silu_f(accv) * 0.08838834764831845f;
        else if (mode == 1) { const float lb = LB[col - 1024]; const float f = lb + (1.0f - lb) * sigmoid_f(accv); LOGF[(size_t)t * 1024 + col - 1024] = log2f(f); o = 1.0f - f; }
        else if (mode == 3 || mode == 7) o = silu_f(accv);
        else if (mode == 4 || mode == 5) {
            const int hi = ci >> 4, d = (col - 4096) & 127;
            const float cs = RC[(size_t)t * 128 + d], sn = RS[(size_t)t * 128 + d];
            const float x1 = hi ? partner : accv, x2 = hi ? accv : partner;
            o = hi ? (x1 * sn + x2 * cs) : (x1 * cs - x2 * sn);
            if (mode == 5) o *= 0.0625f;
        }
        PROJ[(size_t)t * NPROJ + col] = (bf16)f2bf(o);
        __syncthreads();
    }
}

struct Args { const float* in[17]; float* out; unsigned char* ws; };
__global__ void __launch_bounds__(NWAVES * 64, 2) mega_fwd(Args args) {
    extern __shared__ __attribute__((aligned(16))) unsigned char lds_raw[];
    Frame F;
    F.lds = (LAS unsigned char*)lds_raw;
    F.MISC = (volatile LAS unsigned*)(F.lds + MISC_OFF);
#define REFRESH() do { int t_ = threadIdx.x; asm volatile("" : "+v"(t_)); F.tid = t_; F.lane = t_ & 63; } while (0)
    REFRESH(); F.wave = __builtin_amdgcn_readfirstlane(F.tid >> 6); F.G = gridDim.x;
    F.x = args.in[0]; F.meta = args.in[1]; F.ln_in_g = args.in[2]; F.ln_in_b = args.in[3]; F.hlb = args.in[4]; F.w_in = args.in[5]; F.hg_ng = args.in[6]; F.ret_ng = args.in[7];
    F.ret_nb = args.in[8]; F.w_out = args.in[9]; F.ln1_g = args.in[10]; F.ln1_b = args.in[11]; F.w_gate = args.in[12]; F.w_up = args.in[13]; F.w_down = args.in[14];
    F.ln2_g = args.in[15]; F.ln2_b = args.in[16]; F.out = args.out; F.ws = args.ws;
    unsigned char* ws = args.ws;
    float* LB = (float*)(ws + WS_LB); float* ST0 = (float*)(ws + WS_ST0); float* ST1 = (float*)(ws + WS_ST1); bf16* HM = (bf16*)(ws + WS_HM);
    bf16* WINT = (bf16*)(ws + WS_WIN); bf16* WOUTT = (bf16*)(ws + WS_WOUT); bf16* WDOWNT = (bf16*)(ws + WS_WDOWN); bf16* WGUT = (bf16*)(ws + WS_WGU);
    bf16* H0B = (bf16*)(ws + WS_H0B); bf16* MIX = (bf16*)(ws + WS_MIX); bf16* H1B = (bf16*)(ws + WS_H1B); bf16* PROJ = (bf16*)(ws + WS_PROJ);
    float* Z = (float*)(ws + WS_Z); bf16* ACT = (bf16*)(ws + WS_ACT); float* LOGF = (float*)(ws + WS_LOGF);
    float* RC = (float*)((unsigned char*)args.out + DO_RC); float* RS = (float*)((unsigned char*)args.out + DO_RS);
    float* HGO = args.out; float* RETO = args.out + (size_t)SEQ * 1024;
    float* FH = (float*)(ws + WS_FH); float* FR = (float*)(ws + WS_FR); float* LG = (float*)(ws + WS_LG);
    for (int u = F.tid; u < (LDS_BYTES - LDSCTL_OFF) / 4; u += NWAVES * 64) ((LAS unsigned*)(F.lds + LDSCTL_OFF))[u] = 0u;
    __syncthreads();
    XcdBarrier bar = xcd_barrier_post((unsigned*)(ws + WS_CTL) + CW_BAR, F.MISC + 8);
    const int gw = blockIdx.x * NWAVES + F.wave, NGW = F.G * NWAVES;
#ifdef PROBE_A
    int n_stamp = 0;
#define STAMP() do { if (blockIdx.x == 0 && F.tid == 0) ((unsigned long long*)(ws + WS_CTL + 32768))[n_stamp] = __builtin_amdgcn_s_memrealtime(); ++n_stamp; } while (0)
#else
#define STAMP() do {} while (0)
#endif
    STAMP();

    for (int rep_ = 0; rep_ < ((DUP_PHASE == 0) ? 2 : 1); ++rep_) {
    {
        LAS float* scr = (LAS float*)(F.lds + RING_OFF + F.wave * 16384);
        constexpr int I_IN = (DM / 64) * (NPROJ / 32);
        for (int it = gw; it < I_IN; it += NGW) transpose_item<0>(F.w_in, DM, NPROJ, WINT, scr, it, F.lane);
        for (int m = gw; m < SEQ; m += NGW) ln_row(F.x + (size_t)m * DM, false, F.ln_in_g, F.ln_in_b, H0B + (size_t)m * DM, nullptr, ST0 + 2 * m, F.lane);
        if (gw < 16) ln_row(F.meta + (size_t)gw * DM, false, F.ln_in_g, F.ln_in_b, HM + (size_t)gw * DM, nullptr, nullptr, F.lane);
        for (int t = gw; t < LT; t += NGW) {
#pragma unroll
            for (int hh = 0; hh < 2; ++hh) {
                const int d = F.lane + 64 * hh;
                const float invf = (float)pow(10000.0, -(double)d / 128.0);
                const float ang = (float)(t - PADF) * invf;
                RC[(size_t)t * 128 + d] = (float)cos((double)ang); RS[(size_t)t * 128 + d] = (float)sin((double)ang);
            }
        }
        if (gw < 16) { const int jx = gw * 64 + F.lane; LB[jx] = 1.0f / (1.0f + expf(F.hlb[1024 + jx] - F.hlb[jx])); }
        for (int i = blockIdx.x * 512 + F.tid; i < PADF * NPROJ * 2 / 16; i += F.G * 512) *((GAS v4u*)PROJ + i) = (v4u){0u, 0u, 0u, 0u};
        for (int i = blockIdx.x * 512 + F.tid; i < PADF * 1024 * 4 / 16; i += F.G * 512) *((GAS v4u*)LOGF + i) = (v4u){0u, 0u, 0u, 0u};
    }
    xcd_barrier(bar); STAMP(); REFRESH();
    }

    for (int rep_ = 0; rep_ < ((DUP_PHASE == 1) ? 2 : 1); ++rep_) {
    {
        meta_proj(F, WINT, HM, PROJ, LOGF, LB, RC, RS);
        pg8::Gemm g{H0B, WINT, SEQ, NPROJ, DM}; pg8::StaticOrder S; S.init(SEQ, NPROJ, F.G, (int)blockIdx.x);
        pg8::EpiProj E{PROJ, LOGF, LB, RC, RS};
        pg8::gemm_phase<pg8::EpiProj, pg8::StaticOrder, true, true>(F.lds + RING_OFF, g, S, E);
    }
    xcd_barrier(bar); STAMP(); REFRESH();
    }

    for (int rep_ = 0; rep_ < ((DUP_PHASE == 2) ? 2 : 1); ++rep_) {
    {
        for (int it = blockIdx.x; it < 256; it += F.G) {
            if (it < 128) { const int g = it >> 3, h = it & 7; if (g < HG_G - 1) hgrn_scan<0>(F.lds, PROJ, LOGF, HGO, FH, LG, g, h); }
            else { const int i2 = it - 128, g = i2 >> 4, h = (i2 >> 2) & 3, j = i2 & 3; if (g < RT_G - 1) ret_scan<0>(F.lds, PROJ, RETO, FR, g, h, j); }
        }
        LAS float* scr = (LAS float*)(F.lds + RING_OFF + F.wave * 16384);
        constexpr int I_O = (DM / 64) * (DM / 32), I_D = (DFF / 64) * (DM / 32), I_G = (DM / 64) * (DFF / 32);
        for (int it = gw; it < I_O + I_D + 2 * I_G; it += NGW) {
            int r = it;
            if (r < I_O) { transpose_item<0>(F.w_out, DM, DM, WOUTT, scr, r, F.lane); continue; } r -= I_O;
            if (r < I_D) { transpose_item<0>(F.w_down, DFF, DM, WDOWNT, scr, r, F.lane); continue; } r -= I_D;
            if (r < I_G) { transpose_item<1>(F.w_gate, DM, DFF, WGUT, scr, r, F.lane); continue; } r -= I_G;
            transpose_item<2>(F.w_up, DM, DFF, WGUT, scr, r, F.lane);
        }
    }
    xcd_barrier(bar); STAMP(); REFRESH();
    }
    for (int rep_ = 0; rep_ < ((DUP_PHASE == 4) ? 2 : 1); ++rep_) {
    for (int it = blockIdx.x; it < 256; it += F.G) {
        if (it < 128) { const int g = it >> 3, h = it & 7; hgrn_scan<1>(F.lds, PROJ, LOGF, HGO, FH, LG, g, h); }
        else { const int i2 = it - 128, g = i2 >> 4, h = (i2 >> 2) & 3, j = i2 & 3; ret_scan<1>(F.lds, PROJ, RETO, FR, g, h, j); }
    }
    xcd_barrier(bar); STAMP(); REFRESH();
    }

    for (int rep_ = 0; rep_ < ((DUP_PHASE == 5) ? 2 : 1); ++rep_) {
    for (int r = gw; r < SEQ; r += NGW) {
        const int t = r + PADM, c0 = 16 * F.lane;
        {
            f32x4 o[4]; float s = 0.f;
#pragma unroll
            for (int i = 0; i < 4; ++i) { o[i] = *(const GAS f32x4*)(HGO + (size_t)r * 1024 + c0 + 4 * i); s += (o[i].x * o[i].x + o[i].y * o[i].y) + (o[i].z * o[i].z + o[i].w * o[i].w); }
            s += __shfl_xor(s, 1); s += __shfl_xor(s, 2); s += __shfl_xor(s, 4);
            const float rs = 1.0f / sqrtf(s * (1.f / 128.f) + 1e-6f);
            const v4u g0 = *(const GAS v4u*)(PROJ + (size_t)t * NPROJ + 3072 + c0), g1 = *(const GAS v4u*)(PROJ + (size_t)t * NPROJ + 3072 + c0 + 8);
            unsigned wout[8];
#pragma unroll
            for (int i = 0; i < 4; ++i) {
                const f32x4 ng = *(const GAS f32x4*)(F.hg_ng + c0 + 4 * i);
                const unsigned ga = (i < 2) ? g0[2 * i] : g1[2 * (i - 2)], gb = (i < 2) ? g0[2 * i + 1] : g1[2 * (i - 2) + 1];
                const float y0 = o[i].x * rs * ng.x * __uint_as_float(ga << 16), y1 = o[i].y * rs * ng.y * __uint_as_float(ga & 0xffff0000u);
                const float y2 = o[i].z * rs * ng.z * __uint_as_float(gb << 16), y3 = o[i].w * rs * ng.w * __uint_as_float(gb & 0xffff0000u);
                wout[2 * i] = pk2(y0, y1); wout[2 * i + 1] = pk2(y2, y3);
            }
            *(GAS v4u*)(MIX + (size_t)r * DM + c0) = (v4u){wout[0], wout[1], wout[2], wout[3]};
            *(GAS v4u*)(MIX + (size_t)r * DM + c0 + 8) = (v4u){wout[4], wout[5], wout[6], wout[7]};
        }
        {
            f32x4 o[4]; float s = 0.f;
#pragma unroll
            for (int i = 0; i < 4; ++i) { o[i] = *(const GAS f32x4*)(RETO + (size_t)r * 1024 + c0 + 4 * i); s += (o[i].x + o[i].y) + (o[i].z + o[i].w); }
            s += __shfl_xor(s, 1); s += __shfl_xor(s, 2); s += __shfl_xor(s, 4); s += __shfl_xor(s, 8);
            const float mu = s * (1.f / 256.f); float q = 0.f;
#pragma unroll
            for (int i = 0; i < 4; ++i) { o[i] = o[i] - mu; q += (o[i].x * o[i].x + o[i].y * o[i].y) + (o[i].z * o[i].z + o[i].w * o[i].w); }
            q += __shfl_xor(q, 1); q += __shfl_xor(q, 2); q += __shfl_xor(q, 4); q += __shfl_xor(q, 8);
            const float rs = 1.0f / sqrtf(q * (1.f / 256.f) + 1e-6f);
            const v4u g0 = *(const GAS v4u*)(PROJ + (size_t)t * NPROJ + 7168 + c0), g1 = *(const GAS v4u*)(PROJ + (size_t)t * NPROJ + 7168 + c0 + 8);
            unsigned wout[8];
#pragma unroll
            for (int i = 0; i < 4; ++i) {
                const f32x4 ng = *(const GAS f32x4*)(F.ret_ng + c0 + 4 * i), nb = *(const GAS f32x4*)(F.ret_nb + c0 + 4 * i);
                const unsigned ga = (i < 2) ? g0[2 * i] : g1[2 * (i - 2)], gb = (i < 2) ? g0[2 * i + 1] : g1[2 * (i - 2) + 1];
                const float y0 = (o[i].x * rs * ng.x + nb.x) * __uint_as_float(ga << 16), y1 = (o[i].y * rs * ng.y + nb.y) * __uint_as_float(ga & 0xffff0000u);
                const float y2 = (o[i].z * rs * ng.z + nb.z) * __uint_as_float(gb << 16), y3 = (o[i].w * rs * ng.w + nb.w) * __uint_as_float(gb & 0xffff0000u);
                wout[2 * i] = pk2(y0, y1); wout[2 * i + 1] = pk2(y2, y3);
            }
            *(GAS v4u*)(MIX + (size_t)r * DM + 1024 + c0) = (v4u){wout[0], wout[1], wout[2], wout[3]};
            *(GAS v4u*)(MIX + (size_t)r * DM + 1024 + c0 + 8) = (v4u){wout[4], wout[5], wout[6], wout[7]};
        }
    }
    xcd_barrier(bar); STAMP(); REFRESH();
    }

    for (int rep_ = 0; rep_ < ((DUP_PHASE == 6) ? 2 : 1); ++rep_) {
    {
        pg8::Gemm g{MIX, WOUTT, SEQ, DM, DM}; pg8::StaticOrder S; S.init(SEQ, DM, F.G, (int)blockIdx.x);
        pg8::EpiResid E{F.x, ST0, F.ln_in_g, F.ln_in_b, Z};
        pg8::gemm_phase<pg8::EpiResid, pg8::StaticOrder, true, true>(F.lds + RING_OFF, g, S, E);
    }
    xcd_barrier(bar); STAMP(); REFRESH();
    }
    for (int rep_ = 0; rep_ < ((DUP_PHASE == 7) ? 2 : 1); ++rep_) {
#if DUP_PHASE == 99
    for (int xb_ = 0; xb_ < 5; ++xb_) xcd_barrier(bar);
#endif
    for (int m = gw; m < SEQ; m += NGW) ln_row(Z + (size_t)m * DM, false, F.ln1_g, F.ln1_b, H1B + (size_t)m * DM, nullptr, ST1 + 2 * m, F.lane);
    xcd_barrier(bar); STAMP(); REFRESH();
    }
    for (int rep_ = 0; rep_ < ((DUP_PHASE == 8) ? 2 : 1); ++rep_) {
    {
        pg8::Gemm g{H1B, WGUT, SEQ, 2 * DFF, DM}; pg8::StaticOrder S; S.init(SEQ, 2 * DFF, F.G, (int)blockIdx.x);
        pg8::EpiGU E{ACT};
        pg8::gemm_phase<pg8::EpiGU, pg8::StaticOrder, true, true>(F.lds + RING_OFF, g, S, E);
    }
    xcd_barrier(bar); STAMP(); REFRESH();
    }
    for (int rep_ = 0; rep_ < ((DUP_PHASE == 9) ? 2 : 1); ++rep_) {
    {
        pg8::Gemm g{ACT, WDOWNT, SEQ, DM, DFF}; pg8::StaticOrder S; S.init(SEQ, DM, F.G, (int)blockIdx.x);
        pg8::EpiResid E{Z, ST1, F.ln1_g, F.ln1_b, F.out};
        pg8::gemm_phase<pg8::EpiResid, pg8::StaticOrder, true, true>(F.lds + RING_OFF, g, S, E);
    }
    xcd_barrier(bar); STAMP(); REFRESH();
    }
    for (int m = gw; m < SEQ; m += NGW) ln_row(F.out + (size_t)m * DM, false, F.ln2_g, F.ln2_b, nullptr, F.out + (size_t)m * DM, nullptr, F.lane);
#ifdef PROBE_A
    xcd_barrier(bar); STAMP(); REFRESH();
    {
        const unsigned long long* ts = (const unsigned long long*)(ws + WS_CTL + 32768);
        const unsigned long long ta0 = __hip_atomic_load(ts + PROBE_A, RLX_AGENT), ta1 = __hip_atomic_load(ts + PROBE_A + 1, RLX_AGENT);
        const unsigned long long tb0 = __hip_atomic_load(ts + PROBE_B, RLX_AGENT), tb1 = __hip_atomic_load(ts + PROBE_B + 1, RLX_AGENT);
        const float a_us = (float)(ta1 - ta0) * 0.01f, b_us = (float)(tb1 - tb0) * 0.01f;
        if (blockIdx.x == 0 && F.tid == 0) F.out[0] += a_us * 0.01f;
        for (int i = blockIdx.x * 512 + F.tid; i < 32 * DM; i += F.G * 512) F.out[(size_t)4096 * DM + i] += b_us * 0.001f;
    }
#endif
}

extern "C" void kernel_launch(void* const* d_in, const int* in_sizes, int n_in, void* d_out, int out_size, void* d_ws, size_t ws_size, hipStream_t stream) {
    static int grid = 0;
    if (grid == 0) {
        if (n_in != 17 || out_size != SEQ * DM || ws_size < WS_END) { fprintf(stderr, "kernel_launch: unexpected shapes (n_in %d out %d ws %zu)\n", n_in, out_size, ws_size); grid = -1; return; }
        int dev = 0, cus = 0, per_cu = 0;
        if (hipGetDevice(&dev) != hipSuccess || hipDeviceGetAttribute(&cus, hipDeviceAttributeMultiprocessorCount, dev) != hipSuccess) { grid = -1; return; }
        if (hipFuncSetAttribute((const void*)mega_fwd, hipFuncAttributeMaxDynamicSharedMemorySize, LDS_BYTES) != hipSuccess) { fprintf(stderr, "kernel_launch: hipFuncSetAttribute failed\n"); grid = -1; return; }
        if (hipOccupancyMaxActiveBlocksPerMultiprocessor(&per_cu, (const void*)mega_fwd, NWAVES * 64, LDS_BYTES) != hipSuccess || per_cu < 1) { fprintf(stderr, "kernel_launch: occupancy query says %d\n", per_cu); (void)hipGetLastError(); per_cu = 1; }
        grid = cus * 1;
    }
    if (grid < 0) return;
    (void)hipMemsetAsync((char*)d_ws + WS_CTL, 0, CTL_ZERO_BYTES, stream);
    Args a{};
    for (int i = 0; i < 17; ++i) a.in[i] = (const float*)d_in[i];
    a.out = (float*)d_out; a.ws = (unsigned char*)d_ws;
    void* kargs[] = {&a};
    hipError_t e = hipLaunchCooperativeKernel((const void*)mega_fwd, dim3(grid), dim3(NWAVES * 64), kargs, LDS_BYTES, stream);
    if (e != hipSuccess) fprintf(stderr, "kernel_launch: cooperative launch failed: %s (grid %d)\n", hipGetErrorString(e), grid);
}
```
